# Optimizing an MI355X kernel written in HIP

```python
import jax, jax.numpy as jnp
from jax import lax
import numpy as np

D_MODEL = 1024
BATCH = 2
SEQ = 16384
DEPTH = 2

GRID_W = 64
CTX_LEN = 256
EPS = 1e-6
NEG_INF = -1e30

W_A = 256
W_B = 256
W_C = 256
W_D = 256
D_MIX = W_A + W_B + W_C + W_D
N_GROUPS = 4
GROUP_W = D_MIX // N_GROUPS
CONV_A = 3
CONV_B = 31
CHUNK = 128
H_C = 4
DH_C = W_C // H_C
H_D = 4
DH_D = W_D // H_D
WIN_R = 8
WIN_C = 16
OFF_A = 0
OFF_B = OFF_A + 3 * W_A
OFF_C = OFF_B + 2 * W_B
OFF_D = OFF_C + 2 * W_C
OFF_KV = OFF_D + W_D
IN_COLS = OFF_D + 3 * W_D
D_FF = 2816
N_EXPERTS = 8
TOP_K = 2
D_FF_EXPERT = 3584
MOE_BLOCK = 128
N_DENSE = (DEPTH + 1) // 2
N_MOE = DEPTH // 2

kernel_name = "hybrid_headgroup_dit_moe"


def rms_norm(x, g):
    xf = x.astype(jnp.float32)
    y = xf * lax.rsqrt(jnp.mean(xf * xf, axis=-1, keepdims=True) + EPS)
    return (y * g.astype(jnp.float32)).astype(x.dtype)


def layer_norm(x, g, b):
    xf = x.astype(jnp.float32)
    mu = jnp.mean(xf, axis=-1, keepdims=True)
    var = jnp.mean(jnp.square(xf - mu), axis=-1, keepdims=True)
    y = (xf - mu) * lax.rsqrt(var + EPS) * g.astype(jnp.float32) + b.astype(jnp.float32)
    return y.astype(x.dtype)


def modulate(h, shift, scale):
    return h * (1 + scale) + shift


def depthwise_conv(x, w):
    k, ch = w.shape
    return lax.conv_general_dilated(
        x, w.astype(x.dtype)[:, None, :], window_strides=(1,),
        padding=[((k - 1) // 2, k // 2)],
        dimension_numbers=("NWC", "WIO", "NWC"), feature_group_count=ch)


def short_conv(p, w):
    bg, cg, xa = p[..., :W_A], p[..., W_A:2 * W_A], p[..., 2 * W_A:]
    return bg * depthwise_conv(cg * xa, w)


def conformer_conv(p, w, bias, ln_g, ln_b):
    y = p[..., :W_B] * jax.nn.sigmoid(p[..., W_B:])
    y = depthwise_conv(y, w) + bias
    return jax.nn.silu(layer_norm(y, ln_g, ln_b))


def spatial_gating(p, ln_g, ln_b, w_s, b_s):
    b, s, _ = p.shape
    z = jax.nn.gelu(p)
    u, v = z[..., :W_C], z[..., W_C:]
    v = layer_norm(v, ln_g, ln_b).reshape(b, s // CHUNK, CHUNK, H_C, DH_C)
    v = jnp.einsum("hpq,bnqhd->bnphd", w_s, v) + b_s.T[:, :, None]
    return u * v.reshape(b, s, W_C)


def heads(t):
    return t.reshape(*t.shape[:-1], H_D, DH_D)


def neighbourhood_attention(q, k, v, k_ctx, v_ctx, rpb):
    b, n = q.shape[:2]
    rows = n // GRID_W
    kr = min(WIN_R, rows)
    kc = min(WIN_C, GRID_W)
    qg = (q * (DH_D ** -0.5)).reshape(b, rows, GRID_W, H_D, DH_D)
    kg = k.reshape(b, rows, GRID_W, H_D, DH_D)
    vg = v.reshape(b, rows, GRID_W, H_D, DH_D)
    r_idx = jnp.arange(rows)
    key_rows = jnp.clip(r_idx - kr // 2, 0, rows - kr)[:, None] + jnp.arange(kr)[None, :]
    k_blk = kg[:, key_rows]
    v_blk = vg[:, key_rows]
    c_idx = jnp.arange(GRID_W)
    c_start = jnp.clip(c_idx - kc // 2, 0, GRID_W - kc)
    col_ok = (c_idx[None, :] >= c_start[:, None]) & (c_idx[None, :] < c_start[:, None] + kc)
    dr = key_rows - r_idx[:, None] + (WIN_R - 1)
    dc = jnp.clip(c_idx[None, :] - c_idx[:, None], -(WIN_C - 1), WIN_C - 1) + (WIN_C - 1)
    bias = rpb[:, dr[:, None, :, None], dc[None, :, None, :]]
    s_loc = jnp.einsum("brqhd,brkchd->bhrqkc", qg, k_blk).astype(jnp.float32)
    s_loc = jnp.where(col_ok[:, None, :], s_loc + bias.astype(jnp.float32), NEG_INF)
    s_ctx = jnp.einsum("brqhd,blhd->bhrql", qg, k_ctx).astype(jnp.float32)
    n_loc = kr * GRID_W
    logits = jnp.concatenate([s_loc.reshape(b, H_D, rows, GRID_W, n_loc), s_ctx], axis=-1)
    prob = jax.nn.softmax(logits, axis=-1).astype(v.dtype)
    p_loc = prob[..., :n_loc].reshape(b, H_D, rows, GRID_W, kr, GRID_W)
    p_ctx = prob[..., n_loc:]
    out = (jnp.einsum("bhrqkc,brkchd->brqhd", p_loc, v_blk)
           + jnp.einsum("bhrql,blhd->brqhd", p_ctx, v_ctx))
    return out.reshape(b, n, W_D)


def context_attention(q, k, v):
    b, l = q.shape[:2]
    s = jnp.einsum("blhd,bmhd->bhlm", q * (DH_D ** -0.5), k).astype(jnp.float32)
    prob = jax.nn.softmax(s, axis=-1).astype(v.dtype)
    return jnp.einsum("bhlm,bmhd->blhd", prob, v).reshape(b, l, W_D)


def merge_groups(ys, group_g, w_out):
    y = jnp.concatenate(ys, axis=-1)
    y = rms_norm(y.reshape(*y.shape[:-1], N_GROUPS, GROUP_W), group_g.reshape(N_GROUPS, GROUP_W))
    return y.reshape(*y.shape[:-2], D_MIX) @ w_out


def hybrid_mixer(h, hc, w_in, conv_a_w, conv_b_w, conv_b_b, conv_ln_g, conv_ln_b,
                 sgu_ln_g, sgu_ln_b, sgu_w, sgu_b, rpb, group_g, w_out, with_ctx_out):
    p = h @ w_in
    q = heads(p[..., OFF_D:OFF_KV])
    k = heads(p[..., OFF_KV:OFF_KV + W_D])
    v = heads(p[..., OFF_KV + W_D:IN_COLS])
    kv_c = hc @ w_in[:, OFF_KV:IN_COLS]
    k_c, v_c = heads(kv_c[..., :W_D]), heads(kv_c[..., W_D:])
    y = merge_groups([
        short_conv(p[..., OFF_A:OFF_B], conv_a_w),
        conformer_conv(p[..., OFF_B:OFF_C], conv_b_w, conv_b_b, conv_ln_g, conv_ln_b),
        spatial_gating(p[..., OFF_C:OFF_D], sgu_ln_g, sgu_ln_b, sgu_w, sgu_b),
        neighbourhood_attention(q, k, v, k_c, v_c, rpb),
    ], group_g, w_out)
    if not with_ctx_out:
        return y, None
    pc = hc @ w_in[:, :OFF_KV]
    yc = merge_groups([
        short_conv(pc[..., OFF_A:OFF_B], conv_a_w),
        conformer_conv(pc[..., OFF_B:OFF_C], conv_b_w, conv_b_b, conv_ln_g, conv_ln_b),
        spatial_gating(pc[..., OFF_C:OFF_D], sgu_ln_g, sgu_ln_b, sgu_w, sgu_b),
        context_attention(heads(pc[..., OFF_D:OFF_KV]), k_c, v_c),
    ], group_g, w_out)
    return y, yc


def swiglu(h, w1, w3, w2):
    return (jax.nn.silu(h @ w1) * (h @ w3)) @ w2


def moe_swiglu(h, router_w, router_b, w1, w3, w2):
    b, s, d = h.shape
    xt = h.reshape(-1, d)
    t = xt.shape[0]
    logits = (xt @ router_w).astype(jnp.float32) + router_b.astype(jnp.float32)
    top_val, top_idx = lax.top_k(logits, TOP_K)
    gates = jax.nn.softmax(top_val, axis=-1)
    n_assign = t * TOP_K
    e_flat = top_idx.reshape(-1).astype(jnp.int32)
    tok_flat = jnp.repeat(jnp.arange(t, dtype=jnp.int32), TOP_K)
    g_flat = gates.reshape(-1)
    order = jnp.argsort(e_flat)
    e_s, tok_s, g_s = e_flat[order], tok_flat[order], g_flat[order]
    counts = jnp.bincount(e_flat, length=N_EXPERTS).astype(jnp.int32)
    padded = (counts + MOE_BLOCK - 1) // MOE_BLOCK * MOE_BLOCK
    pad_end = jnp.cumsum(padded)
    pad_start = pad_end - padded
    start = jnp.cumsum(counts) - counts
    pos = pad_start[e_s] + jnp.arange(n_assign, dtype=jnp.int32) - start[e_s]
    total = -(-n_assign // MOE_BLOCK) * MOE_BLOCK + N_EXPERTS * MOE_BLOCK
    n_blk = total // MOE_BLOCK
    buf_tok = jnp.full((total,), t, jnp.int32).at[pos].set(tok_s)
    buf_gate = jnp.zeros((total,), jnp.float32).at[pos].set(g_s)
    blk_exp = jnp.minimum(jnp.searchsorted(pad_end, jnp.arange(n_blk, dtype=jnp.int32) * MOE_BLOCK,
                                           side="right"), N_EXPERTS - 1)
    x_pad = jnp.concatenate([xt, jnp.zeros((1, d), xt.dtype)], axis=0)
    xb = x_pad[buf_tok].reshape(n_blk, MOE_BLOCK, d)

    def expert_block(args):
        xblk, e = args
        return swiglu(xblk, w1[e], w3[e], w2[e])

    yb = lax.map(expert_block, (xb, blk_exp)).reshape(total, d)
    yb = yb * buf_gate[:, None].astype(yb.dtype)
    out = jnp.zeros((t + 1, d), yb.dtype).at[buf_tok].add(yb)[:t]
    return out.reshape(b, s, d)


def setup_inputs(seed: int = 0) -> dict:
    key = jax.random.key(seed)
    ks = jax.random.split(key, 32)
    L = DEPTH

    def nrm(k, shape, scale):
        return jax.random.normal(k, shape, jnp.float32) * scale

    return {
        "x": nrm(ks[0], (BATCH, SEQ, D_MODEL), 1.0),
        "c": nrm(ks[1], (BATCH, D_MODEL), 1.0),
        "ctx": nrm(ks[2], (BATCH, CTX_LEN, D_MODEL), 1.0),
        "c_ctx": nrm(ks[3], (D_MODEL,), 1.0),
        "w_mod": nrm(ks[4], (L, D_MODEL, 6 * D_MODEL), 0.5 * D_MODEL ** -0.5),
        "b_mod": nrm(ks[5], (L, 6 * D_MODEL), 0.01),
        "norm1_g": 1.0 + nrm(ks[6], (L, D_MODEL), 0.1),
        "norm2_g": 1.0 + nrm(ks[7], (L, D_MODEL), 0.1),
        "w_in": nrm(ks[8], (L, D_MODEL, IN_COLS), D_MODEL ** -0.5),
        "conv_a_w": nrm(ks[9], (L, CONV_A, W_A), CONV_A ** -0.5),
        "conv_b_w": nrm(ks[10], (L, CONV_B, W_B), CONV_B ** -0.5),
        "conv_b_b": nrm(ks[11], (L, W_B), 0.02),
        "conv_ln_g": 1.0 + nrm(ks[12], (L, W_B), 0.1),
        "conv_ln_b": nrm(ks[13], (L, W_B), 0.1),
        "sgu_ln_g": 1.0 + nrm(ks[14], (L, W_C), 0.1),
        "sgu_ln_b": nrm(ks[15], (L, W_C), 0.1),
        "sgu_w": nrm(ks[16], (L, H_C, CHUNK, CHUNK), CHUNK ** -0.5),
        "sgu_b": 1.0 + nrm(ks[17], (L, H_C, CHUNK), 0.1),
        "rpb": nrm(ks[18], (L, H_D, 2 * WIN_R - 1, 2 * WIN_C - 1), 0.1),
        "group_g": 1.0 + nrm(ks[19], (L, D_MIX), 0.1),
        "w_out": nrm(ks[20], (L, D_MIX, D_MODEL), D_MIX ** -0.5),
        "ffn_w1": nrm(ks[21], (N_DENSE, D_MODEL, D_FF), D_MODEL ** -0.5),
        "ffn_w3": nrm(ks[22], (N_DENSE, D_MODEL, D_FF), D_MODEL ** -0.5),
        "ffn_w2": nrm(ks[23], (N_DENSE, D_FF, D_MODEL), D_FF ** -0.5),
        "router_w": nrm(ks[24], (N_MOE, D_MODEL, N_EXPERTS), D_MODEL ** -0.5),
        "router_b": nrm(ks[25], (N_MOE, N_EXPERTS), 0.01),
        "moe_w1": nrm(ks[26], (N_MOE, N_EXPERTS, D_MODEL, D_FF_EXPERT), D_MODEL ** -0.5),
        "moe_w3": nrm(ks[27], (N_MOE, N_EXPERTS, D_MODEL, D_FF_EXPERT), D_MODEL ** -0.5),
        "moe_w2": nrm(ks[28], (N_MOE, N_EXPERTS, D_FF_EXPERT, D_MODEL), D_FF_EXPERT ** -0.5),
        "final_g": 1.0 + nrm(ks[29], (D_MODEL,), 0.1),
    }


def reference(x, c, ctx, c_ctx, w_mod, b_mod, norm1_g, norm2_g, w_in, conv_a_w, conv_b_w,
              conv_b_b, conv_ln_g, conv_ln_b, sgu_ln_g, sgu_ln_b, sgu_w, sgu_b, rpb, group_g,
              w_out, ffn_w1, ffn_w3, ffn_w2, router_w, router_b, moe_w1, moe_w3, moe_w2, final_g):
    xl, xc = x, ctx
    n_ctx = ctx.shape[1]
    sc_lat = jax.nn.silu(c)
    sc_ctx = jax.nn.silu(c_ctx)
    for l in range(DEPTH):
        last = l == DEPTH - 1
        mod = (sc_lat @ w_mod[l] + b_mod[l])[:, None, :]
        mod_c = sc_ctx @ w_mod[l] + b_mod[l]
        sh1, s1, g1, sh2, s2, g2 = jnp.split(mod, 6, axis=-1)
        csh1, cs1, cg1, csh2, cs2, cg2 = jnp.split(mod_c, 6, axis=-1)
        h = modulate(rms_norm(xl, norm1_g[l]), sh1, s1)
        hc = modulate(rms_norm(xc, norm1_g[l]), csh1, cs1)
        y, yc = hybrid_mixer(h, hc, w_in[l], conv_a_w[l], conv_b_w[l], conv_b_b[l], conv_ln_g[l],
                             conv_ln_b[l], sgu_ln_g[l], sgu_ln_b[l], sgu_w[l], sgu_b[l], rpb[l],
                             group_g[l], w_out[l], not last)
        xl = xl + g1 * y
        h = modulate(rms_norm(xl, norm2_g[l]), sh2, s2)
        if not last:
            xc = xc + cg1 * yc
            hc = modulate(rms_norm(xc, norm2_g[l]), csh2, cs2)
            h = jnp.concatenate([hc, h], axis=1)
        if l % 2 == 0:
            f = swiglu(h, ffn_w1[l // 2], ffn_w3[l // 2], ffn_w2[l // 2])
        else:
            f = moe_swiglu(h, router_w[l // 2], router_b[l // 2], moe_w1[l // 2],
                           moe_w3[l // 2], moe_w2[l // 2])
        if not last:
            xc = xc + cg2 * f[:, :n_ctx]
            f = f[:, n_ctx:]
        xl = xl + g2 * f
    return rms_norm(xl, final_g)
```

```cpp
#include <hip/hip_runtime.h>
#include <stdint.h>
#include <stdio.h>

constexpr int D = 1024, BATCH = 2, SEQ = 16384, NCTX = 256;
constexpr int MLAT = BATCH * SEQ;
constexpr int MCTX = BATCH * NCTX;
constexpr int MT = MLAT + MCTX;
constexpr int INC = 2560;
constexpr int OFF_A = 0, OFF_B = 768, OFF_C = 1280, OFF_D = 1792, OFF_KV = 2048;
constexpr int DFF = 2816, NEXP = 8, DFE = 3584;
constexpr int GRID_W = 64, GROWS = SEQ / GRID_W;
constexpr float EPS = 1e-6f;
constexpr int MODW = 6 * D;
constexpr int PADR = 256;
constexpr int MOE_ROWS = 2 * MLAT + NEXP * PADR;
constexpr int MOE_CHUNK = 33792;

typedef unsigned short bf16_t;
__device__ __forceinline__ float bf2f(bf16_t u) { return __uint_as_float(((unsigned)u) << 16); }
__device__ __forceinline__ bf16_t f2bf(float f) { unsigned u = __float_as_uint(f); return (bf16_t)((u + 0x7fffu + ((u >> 16) & 1u)) >> 16); }
__device__ __forceinline__ float wave_sum(float v) {
#pragma unroll
    for (int o = 1; o < 64; o <<= 1) v += __shfl_xor(v, o);
    return v;
}
__device__ __forceinline__ float wave_max(float v) {
#pragma unroll
    for (int o = 1; o < 64; o <<= 1) v = fmaxf(v, __shfl_xor(v, o));
    return v;
}
__device__ __forceinline__ float silu_f(float x) { return x / (1.f + __expf(-x)); }
__device__ __forceinline__ float sigmoid_f(float x) { return 1.f / (1.f + __expf(-x)); }
__device__ __forceinline__ float gelu_tanh_f(float x) { const float u = 0.7978845608028654f * (x + 0.044715f * x * x * x); return 0.5f * x * (1.f + tanhf(u)); }
__device__ __forceinline__ int row_modset(int r) { return r < MLAT ? r / SEQ : 2; }
__device__ __forceinline__ void row_seq(int r, int& s0, int& len) {
    if (r < MLAT) { s0 = (r / SEQ) * SEQ; len = SEQ; } else { s0 = MLAT + ((r - MLAT) / NCTX) * NCTX; len = NCTX; }
}

constexpr size_t MiB = 1ull << 20;
constexpr size_t WS_CTL = 0;
constexpr size_t WS_MOD = 1 * MiB;
constexpr size_t WS_XC = 2 * MiB;
constexpr size_t WS_H = 4 * MiB;
constexpr size_t WS_YMIX = 70 * MiB;
constexpr size_t WS_P = 136 * MiB;
constexpr size_t WS_G = 136 * MiB;
constexpr size_t WS_YRAW = 368 * MiB;
constexpr size_t WS_TMPB = 500 * MiB;
constexpr size_t WS_TMPC = 533 * MiB;
constexpr size_t WS_ROUTE = 566 * MiB;
constexpr size_t WS_END = 568 * MiB;
constexpr size_t RT_SELE = 0;
constexpr size_t RT_SELG = RT_SELE + (size_t)MLAT * 2 * 4;
constexpr size_t RT_SELP = RT_SELG + (size_t)MLAT * 2 * 4;
constexpr size_t RT_SLOTTOK = RT_SELP + (size_t)MLAT * 2 * 4;
constexpr size_t RT_SLOTG = RT_SLOTTOK + (size_t)MOE_ROWS * 4;
constexpr size_t RT_CNT = RT_SLOTG + (size_t)MOE_ROWS * 4;
static_assert(RT_CNT + 256 <= 2 * MiB, "route map");

__global__ void k_mod(const float* __restrict__ c, const float* __restrict__ c_ctx, const float* __restrict__ w_mod, const float* __restrict__ b_mod, float* __restrict__ mod) {
    const int idx = blockIdx.x * 256 + threadIdx.x;
    if (idx >= 2 * 3 * MODW) return;
    const int j = idx % MODW, s = (idx / MODW) % 3, l = idx / (3 * MODW);
    const float* cv = s < 2 ? c + s * D : c_ctx;
    float acc = b_mod[l * MODW + j];
    for (int k = 0; k < D; ++k) acc += silu_f(cv[k]) * w_mod[((size_t)l * D + k) * MODW + j];
    mod[(l * 3 + s) * MODW + j] = acc;
}

__global__ void k_norm_mod(const float* __restrict__ xlat, const float* __restrict__ xctx, const float* __restrict__ g, const float* __restrict__ modl, int chunk_shift, int chunk_scale,
                           bf16_t* __restrict__ H, int r0, int r1) {
    const int lane = threadIdx.x & 63;
    const int row = r0 + blockIdx.x * 4 + (threadIdx.x >> 6);
    if (row >= r1) return;
    const float* src = row < MLAT ? xlat + (size_t)row * D : xctx + (size_t)(row - MLAT) * D;
    const float* md = modl + row_modset(row) * MODW;
    float4 v[4]; float ss = 0.f;
#pragma unroll
    for (int j = 0; j < 4; ++j) { v[j] = *(const float4*)(src + (lane + 64 * j) * 4); ss += v[j].x * v[j].x + v[j].y * v[j].y + v[j].z * v[j].z + v[j].w * v[j].w; }
    const float rstd = rsqrtf(wave_sum(ss) * (1.f / D) + EPS);
#pragma unroll
    for (int j = 0; j < 4; ++j) {
        const int col = (lane + 64 * j) * 4;
        const float4 gg = *(const float4*)(g + col), sc = *(const float4*)(md + chunk_scale * D + col), sh = *(const float4*)(md + chunk_shift * D + col);
        ushort4 o;
        o.x = f2bf(v[j].x * rstd * gg.x * (1.f + sc.x) + sh.x); o.y = f2bf(v[j].y * rstd * gg.y * (1.f + sc.y) + sh.y);
        o.z = f2bf(v[j].z * rstd * gg.z * (1.f + sc.z) + sh.z); o.w = f2bf(v[j].w * rstd * gg.w * (1.f + sc.w) + sh.w);
        *(ushort4*)(H + (size_t)row * D + col) = o;
    }
}

struct GemmArgs {
    const bf16_t* A; int lda; const int* gather;
    const float* W; const float* W2; int ldw;
    size_t wstride;
    const int* ebase;
    int M, N, K; int row0;
    bf16_t* Cb; int ldc; int crow0;
    const float* base_lat; const float* base_ctx; float* out_lat; float* out_ctx; const float* gate;
    float* F; const float* slot_gate;
};
template <int EPI> __global__ __launch_bounds__(256) void k_gemm(GemmArgs a) {
    __shared__ float sA[16][68];
    __shared__ float sB[16][68];
    __shared__ float sB2[EPI == 1 ? 16 : 1][68];
    const int tid = threadIdx.x, tx = tid & 15, ty = tid >> 4;
    const int rowt = a.row0 + blockIdx.y * 64, n0 = blockIdx.x * 64;
    const float* W = a.W; const float* W2 = a.W2;
    if (a.ebase) {
        if (rowt >= a.ebase[NEXP]) return;
        int e = 0;
        while (e < NEXP - 1 && rowt >= a.ebase[e + 1]) ++e;
        W += (size_t)e * a.wstride; if (EPI == 1) W2 += (size_t)e * a.wstride;
    }
    float acc[4][4] = {}, acc2[4][4] = {};
    const int ar = tid >> 2, akq = (tid & 3) * 4;
    int arow = rowt + ar;
    if (a.gather) arow = a.gather[arow];
    const bf16_t* ap = arow >= 0 ? a.A + (size_t)arow * a.lda + akq : nullptr;
    const int bk = tid >> 4, bn = (tid & 15) * 4;
    for (int k0 = 0; k0 < a.K; k0 += 16) {
        ushort4 av = ap ? *(const ushort4*)(ap + k0) : make_ushort4(0, 0, 0, 0);
        sA[akq + 0][ar] = bf2f(av.x); sA[akq + 1][ar] = bf2f(av.y); sA[akq + 2][ar] = bf2f(av.z); sA[akq + 3][ar] = bf2f(av.w);
        const float4 bv = *(const float4*)(W + (size_t)(k0 + bk) * a.ldw + n0 + bn);
        sB[bk][bn + 0] = bv.x; sB[bk][bn + 1] = bv.y; sB[bk][bn + 2] = bv.z; sB[bk][bn + 3] = bv.w;
        if (EPI == 1) { const float4 b2 = *(const float4*)(W2 + (size_t)(k0 + bk) * a.ldw + n0 + bn);
            sB2[bk][bn + 0] = b2.x; sB2[bk][bn + 1] = b2.y; sB2[bk][bn + 2] = b2.z; sB2[bk][bn + 3] = b2.w; }
        __syncthreads();
#pragma unroll
        for (int kk = 0; kk < 16; ++kk) {
            float av4[4], bv4[4], cv4[4];
#pragma unroll
            for (int i = 0; i < 4; ++i) { av4[i] = sA[kk][ty * 4 + i]; bv4[i] = sB[kk][tx * 4 + i]; if (EPI == 1) cv4[i] = sB2[kk][tx * 4 + i]; }
#pragma unroll
            for (int i = 0; i < 4; ++i)
#pragma unroll
                for (int j = 0; j < 4; ++j) { acc[i][j] += av4[i] * bv4[j]; if (EPI == 1) acc2[i][j] += av4[i] * cv4[j]; }
        }
        __syncthreads();
    }
#pragma unroll
    for (int i = 0; i < 4; ++i) {
        const int row = rowt + ty * 4 + i;
#pragma unroll
        for (int j = 0; j < 4; ++j) {
            const int col = n0 + tx * 4 + j;
            if (EPI == 0) a.Cb[(size_t)(row - a.crow0) * a.ldc + col] = f2bf(acc[i][j]);
            else if (EPI == 1) a.Cb[(size_t)(row - a.crow0) * a.ldc + col] = f2bf(silu_f(acc[i][j]) * acc2[i][j]);
            else if (EPI == 2) {
                const float gt = a.gate[row_modset(row) * MODW + col];
                if (row < MLAT) a.out_lat[(size_t)row * D + col] = a.base_lat[(size_t)row * D + col] + gt * acc[i][j];
                else a.out_ctx[(size_t)(row - MLAT) * D + col] = a.base_ctx[(size_t)(row - MLAT) * D + col] + gt * acc[i][j];
            } else {
                const int tok = a.gather ? -1 : 0; (void)tok;
            }
        }
    }
}
__global__ __launch_bounds__(256) void k_gemm_moe2(const bf16_t* __restrict__ G, int grow0, const float* __restrict__ w2, const int* __restrict__ ebase, const int* __restrict__ slot_tok,
                                                   const float* __restrict__ slot_gate, float* __restrict__ F, int row0, int rows) {
    __shared__ float sA[16][68];
    __shared__ float sB[16][68];
    const int tid = threadIdx.x, tx = tid & 15, ty = tid >> 4;
    const int rowt = row0 + blockIdx.y * 64, n0 = blockIdx.x * 64;
    if (rowt >= ebase[NEXP] || rowt >= row0 + rows) return;
    int e = 0;
    while (e < NEXP - 1 && rowt >= ebase[e + 1]) ++e;
    const float* W = w2 + (size_t)e * DFE * D;
    float acc[4][4] = {};
    const int ar = tid >> 2, akq = (tid & 3) * 4;
    const bf16_t* ap = G + (size_t)(rowt + ar - grow0) * DFE + akq;
    const int bk = tid >> 4, bn = (tid & 15) * 4;
    for (int k0 = 0; k0 < DFE; k0 += 16) {
        const ushort4 av = *(const ushort4*)(ap + k0);
        sA[akq + 0][ar] = bf2f(av.x); sA[akq + 1][ar] = bf2f(av.y); sA[akq + 2][ar] = bf2f(av.z); sA[akq + 3][ar] = bf2f(av.w);
        const float4 bv = *(const float4*)(W + (size_t)(k0 + bk) * D + n0 + bn);
        sB[bk][bn + 0] = bv.x; sB[bk][bn + 1] = bv.y; sB[bk][bn + 2] = bv.z; sB[bk][bn + 3] = bv.w;
        __syncthreads();
#pragma unroll
        for (int kk = 0; kk < 16; ++kk) {
            float av4[4], bv4[4];
#pragma unroll
            for (int i = 0; i < 4; ++i) { av4[i] = sA[kk][ty * 4 + i]; bv4[i] = sB[kk][tx * 4 + i]; }
#pragma unroll
            for (int i = 0; i < 4; ++i)
#pragma unroll
                for (int j = 0; j < 4; ++j) acc[i][j] += av4[i] * bv4[j];
        }
        __syncthreads();
    }
#pragma unroll
    for (int i = 0; i < 4; ++i) {
        const int row = rowt + ty * 4 + i; const int tok = slot_tok[row];
        if (tok < 0) continue;
        const float gt = slot_gate[row];
#pragma unroll
        for (int j = 0; j < 4; ++j) atomicAdd(F + (size_t)tok * D + n0 + tx * 4 + j, gt * acc[i][j]);
    }
}

__global__ void k_mixA(const bf16_t* __restrict__ P, const float* __restrict__ wA  , float* __restrict__ YRAW, int r0, int r1) {
    const int idx = blockIdx.x * 256 + threadIdx.x; const int row = r0 + idx / 256, ch = idx % 256;
    if (row >= r1) return;
    int s0, len; row_seq(row, s0, len); const int t = row - s0;
    float acc = 0.f;
    for (int j = 0; j < 3; ++j) { const int tt = t + j - 1; if (tt < 0 || tt >= len) continue;
        const bf16_t* pr = P + (size_t)(s0 + tt) * INC + OFF_A; acc += wA[j * 256 + ch] * (bf2f(pr[256 + ch]) * bf2f(pr[512 + ch])); }
    YRAW[(size_t)row * D + ch] = bf2f(P[(size_t)row * INC + OFF_A + ch]) * acc;
}
__global__ void k_mixB1(const bf16_t* __restrict__ P, const float* __restrict__ wB  , const float* __restrict__ bB, float* __restrict__ TMP, int r0, int r1) {
    const int idx = blockIdx.x * 256 + threadIdx.x; const int row = r0 + idx / 256, ch = idx % 256;
    if (row >= r1) return;
    int s0, len; row_seq(row, s0, len); const int t = row - s0;
    float acc = bB[ch];
    for (int j = 0; j < 31; ++j) { const int tt = t + j - 15; if (tt < 0 || tt >= len) continue;
        const bf16_t* pr = P + (size_t)(s0 + tt) * INC + OFF_B; acc += wB[j * 256 + ch] * (bf2f(pr[ch]) * sigmoid_f(bf2f(pr[256 + ch]))); }
    TMP[(size_t)row * 256 + ch] = acc;
}
template <int MODE> __global__ void k_ln256(const float* __restrict__ TMPin, const bf16_t* __restrict__ P, const float* __restrict__ g, const float* __restrict__ b, float* __restrict__ dst, int r0, int r1) {
    const int lane = threadIdx.x & 63; const int row = r0 + blockIdx.x * 4 + (threadIdx.x >> 6);
    if (row >= r1) return;
    float v[4];
#pragma unroll
    for (int i = 0; i < 4; ++i) { const int ch = lane * 4 + i; v[i] = MODE == 0 ? TMPin[(size_t)row * 256 + ch] : gelu_tanh_f(bf2f(P[(size_t)row * INC + OFF_C + 256 + ch])); }
    const float mu = wave_sum(v[0] + v[1] + v[2] + v[3]) * (1.f / 256.f);
    float q = 0.f;
#pragma unroll
    for (int i = 0; i < 4; ++i) { v[i] -= mu; q += v[i] * v[i]; }
    const float rstd = rsqrtf(wave_sum(q) * (1.f / 256.f) + EPS);
#pragma unroll
    for (int i = 0; i < 4; ++i) { const int ch = lane * 4 + i; const float y = v[i] * rstd * g[ch] + b[ch];
        if (MODE == 0) dst[(size_t)row * D + 256 + ch] = silu_f(y); else dst[(size_t)row * 256 + ch] = y; }
}
__global__ void k_mixC2(const bf16_t* __restrict__ P, const float* __restrict__ VN  , const float* __restrict__ ws  , const float* __restrict__ bs  , float* __restrict__ YRAW, int r0, int r1) {
    const int idx = blockIdx.x * 256 + threadIdx.x; const int row = r0 + idx / 256, ch = idx % 256;
    if (row >= r1) return;
    int s0, len; row_seq(row, s0, len); const int t = row - s0; const int cb = s0 + (t / 128) * 128, pl = t % 128, h = ch / 64;
    float acc = bs[h * 128 + pl];
    const float* wr = ws + ((size_t)h * 128 + pl) * 128;
    for (int q = 0; q < 128; ++q) acc += wr[q] * VN[(size_t)(cb + q) * 256 + ch];
    YRAW[(size_t)row * D + 512 + ch] = gelu_tanh_f(bf2f(P[(size_t)row * INC + OFF_C + ch])) * acc;
}
__global__ __launch_bounds__(256) void k_attn(const bf16_t* __restrict__ P, const float* __restrict__ rpb  , float* __restrict__ YRAW, int r0, int r1) {
    __shared__ float sc[4][384];
    const int lane = threadIdx.x & 63, w = threadIdx.x >> 6;
    const int item = blockIdx.x * 4 + w; const int row = r0 + item / 4, h = item % 4;
    if (row >= r1) return;
    const bool lat = row < MLAT;
    const int b = lat ? row / SEQ : (row - MLAT) / NCTX;
    const int t = lat ? row % SEQ : 0, gr = t / GRID_W, gc = t % GRID_W;
    const int kr0 = min(max(gr - 4, 0), GROWS - 8), c0 = min(max(gc - 8, 0), GRID_W - 16);
    const int nloc = lat ? 128 : 0, nk = nloc + NCTX;
    const float q = bf2f(P[(size_t)row * INC + OFF_D + h * 64 + lane]) * 0.125f;
    float* s = sc[w];
    for (int i = 0; i < nk; ++i) {
        int krow; float bias = 0.f;
        if (i < nloc) { const int kr = kr0 + i / 16, kc = c0 + i % 16; krow = b * SEQ + kr * GRID_W + kc; bias = rpb[(h * 15 + (kr - gr + 7)) * 31 + (kc - gc + 15)]; }
        else krow = MLAT + b * NCTX + (i - nloc);
        const float d = wave_sum(q * bf2f(P[(size_t)krow * INC + OFF_KV + h * 64 + lane])) + bias;
        if (lane == 0) s[i] = d;
    }
    __syncthreads();
    float m = -1e30f;
    for (int i = lane; i < nk; i += 64) m = fmaxf(m, s[i]);
    m = wave_max(m);
    float sum = 0.f;
    for (int i = lane; i < nk; i += 64) { const float e = __expf(s[i] - m); s[i] = e; sum += e; }
    sum = wave_sum(sum);
    __syncthreads();
    float o = 0.f;
    for (int i = 0; i < nk; ++i) {
        int krow;
        if (i < nloc) { const int kr = kr0 + i / 16, kc = c0 + i % 16; krow = b * SEQ + kr * GRID_W + kc; }
        else krow = MLAT + b * NCTX + (i - nloc);
        o += s[i] * bf2f(P[(size_t)krow * INC + OFF_KV + 256 + h * 64 + lane]);
    }
    YRAW[(size_t)row * D + 768 + h * 64 + lane] = o / sum;
}
__global__ void k_groupnorm(const float* __restrict__ YRAW, const float* __restrict__ gg  , bf16_t* __restrict__ YMIX, int r0, int r1) {
    const int lane = threadIdx.x & 63; const int item = blockIdx.x * 4 + (threadIdx.x >> 6); const int row = r0 + item / 4, g = item % 4;
    if (row >= r1) return;
    const float4 v = *(const float4*)(YRAW + (size_t)row * D + g * 256 + lane * 4);
    const float rstd = rsqrtf(wave_sum(v.x * v.x + v.y * v.y + v.z * v.z + v.w * v.w) * (1.f / 256.f) + EPS);
    const float4 w = *(const float4*)(gg + g * 256 + lane * 4);
    ushort4 o; o.x = f2bf(v.x * rstd * w.x); o.y = f2bf(v.y * rstd * w.y); o.z = f2bf(v.z * rstd * w.z); o.w = f2bf(v.w * rstd * w.w);
    *(ushort4*)(YMIX + (size_t)row * D + g * 256 + lane * 4) = o;
}

__global__ void k_route(const float* __restrict__ xl, const float* __restrict__ g, const float* __restrict__ modl, const float* __restrict__ rw  , const float* __restrict__ rb,
                        bf16_t* __restrict__ H, int* __restrict__ sel_e, float* __restrict__ sel_g) {
    const int lane = threadIdx.x & 63; const int row = blockIdx.x * 4 + (threadIdx.x >> 6);
    if (row >= MLAT) return;
    const float* src = xl + (size_t)row * D; const float* md = modl + row_modset(row) * MODW;
    float4 v[4]; float ss = 0.f;
#pragma unroll
    for (int j = 0; j < 4; ++j) { v[j] = *(const float4*)(src + (lane + 64 * j) * 4); ss += v[j].x * v[j].x + v[j].y * v[j].y + v[j].z * v[j].z + v[j].w * v[j].w; }
    const float rstd = rsqrtf(wave_sum(ss) * (1.f / D) + EPS);
    float lg[NEXP] = {};
#pragma unroll
    for (int j = 0; j < 4; ++j) {
        const int col = (lane + 64 * j) * 4;
        const float4 gg = *(const float4*)(g + col), sc = *(const float4*)(md + 4 * D + col), sh = *(const float4*)(md + 3 * D + col);
        float hv[4] = {v[j].x * rstd * gg.x * (1.f + sc.x) + sh.x, v[j].y * rstd * gg.y * (1.f + sc.y) + sh.y, v[j].z * rstd * gg.z * (1.f + sc.z) + sh.z, v[j].w * rstd * gg.w * (1.f + sc.w) + sh.w};
        ushort4 o; o.x = f2bf(hv[0]); o.y = f2bf(hv[1]); o.z = f2bf(hv[2]); o.w = f2bf(hv[3]);
        *(ushort4*)(H + (size_t)row * D + col) = o;
#pragma unroll
        for (int i = 0; i < 4; ++i) {
            const float4 w0 = *(const float4*)(rw + (size_t)(col + i) * NEXP), w1 = *(const float4*)(rw + (size_t)(col + i) * NEXP + 4);
            lg[0] += hv[i] * w0.x; lg[1] += hv[i] * w0.y; lg[2] += hv[i] * w0.z; lg[3] += hv[i] * w0.w; lg[4] += hv[i] * w1.x; lg[5] += hv[i] * w1.y; lg[6] += hv[i] * w1.z; lg[7] += hv[i] * w1.w;
        }
    }
#pragma unroll
    for (int e = 0; e < NEXP; ++e) lg[e] = wave_sum(lg[e]) + rb[e];
    int e0 = 0; float v0 = lg[0];
#pragma unroll
    for (int e = 1; e < NEXP; ++e) if (lg[e] > v0) { v0 = lg[e]; e0 = e; }
    int e1 = -1; float v1 = -3.4e38f;
#pragma unroll
    for (int e = 0; e < NEXP; ++e) if (e != e0 && lg[e] > v1) { v1 = lg[e]; e1 = e; }
    const float p1 = __expf(v1 - v0), inv = 1.f / (1.f + p1);
    if (lane == 0) { sel_e[row * 2] = e0; sel_e[row * 2 + 1] = e1; sel_g[row * 2] = inv; sel_g[row * 2 + 1] = p1 * inv; }
}
__global__ __launch_bounds__(1024) void k_moe_plan(const int* __restrict__ sel_e, int* __restrict__ sel_p, int* __restrict__ cnt) {
    __shared__ int sc[1024];
    const int e = blockIdx.x, tid = threadIdx.x; int c = 0;
    for (int i = 0; i < 64; ++i) c += sel_e[tid * 64 + i] == e;
    sc[tid] = c; __syncthreads();
    for (int o = 1; o < 1024; o <<= 1) { int v = tid >= o ? sc[tid - o] : 0; __syncthreads(); sc[tid] += v; __syncthreads(); }
    int pos = sc[tid] - c;
    for (int i = 0; i < 64; ++i) if (sel_e[tid * 64 + i] == e) sel_p[tid * 64 + i] = pos++;
    if (tid == 1023) cnt[e] = sc[1023];
}
__global__ void k_moe_base(int* __restrict__ cnt) {
    if (threadIdx.x == 0) { int b = 0; for (int e = 0; e < NEXP; ++e) { cnt[16 + e] = b; b += (cnt[e] + PADR - 1) / PADR * PADR; } cnt[16 + NEXP] = b; }
}
__global__ void k_moe_fill(const int* __restrict__ sel_e, const float* __restrict__ sel_g, const int* __restrict__ sel_p, const int* __restrict__ cnt, int* __restrict__ slot_tok, float* __restrict__ slot_g) {
    const int i = blockIdx.x * 256 + threadIdx.x; if (i >= MLAT * 2) return;
    const int slot = cnt[16 + sel_e[i]] + sel_p[i]; slot_tok[slot] = i >> 1; slot_g[slot] = sel_g[i];
}
__global__ void k_final(const float* __restrict__ xl, const float* __restrict__ F, const float* __restrict__ modl, const float* __restrict__ fg, float* __restrict__ out) {
    const int lane = threadIdx.x & 63; const int row = blockIdx.x * 4 + (threadIdx.x >> 6);
    if (row >= MLAT) return;
    const float* md = modl + row_modset(row) * MODW + 5 * D;
    float4 v[4]; float ss = 0.f;
#pragma unroll
    for (int j = 0; j < 4; ++j) { const int col = (lane + 64 * j) * 4; const float4 x = *(const float4*)(xl + (size_t)row * D + col), f = *(const float4*)(F + (size_t)row * D + col), g2 = *(const float4*)(md + col);
        v[j] = make_float4(x.x + g2.x * f.x, x.y + g2.y * f.y, x.z + g2.z * f.z, x.w + g2.w * f.w); ss += v[j].x * v[j].x + v[j].y * v[j].y + v[j].z * v[j].z + v[j].w * v[j].w; }
    const float rstd = rsqrtf(wave_sum(ss) * (1.f / D) + EPS);
#pragma unroll
    for (int j = 0; j < 4; ++j) { const int col = (lane + 64 * j) * 4; const float4 g = *(const float4*)(fg + col);
        *(float4*)(out + (size_t)row * D + col) = make_float4(v[j].x * rstd * g.x, v[j].y * rstd * g.y, v[j].z * rstd * g.z, v[j].w * rstd * g.w); }
}

extern "C" void kernel_launch(void* const* d_in, const int* in_sizes, int n_in, void* d_out, int out_size, void* d_ws, size_t ws_size, hipStream_t stream) {
    if (n_in != 30 || out_size != MLAT * D || ws_size < WS_END) { fprintf(stderr, "kernel_launch: unexpected shapes / workspace (%d inputs, out %d, ws %zu)\n", n_in, out_size, ws_size); return; }
    const float* x = (const float*)d_in[0]; const float* c = (const float*)d_in[1]; const float* ctx = (const float*)d_in[2]; const float* c_ctx = (const float*)d_in[3];
    const float* w_mod = (const float*)d_in[4]; const float* b_mod = (const float*)d_in[5]; const float* norm1_g = (const float*)d_in[6]; const float* norm2_g = (const float*)d_in[7];
    const float* w_in = (const float*)d_in[8]; const float* conv_a_w = (const float*)d_in[9]; const float* conv_b_w = (const float*)d_in[10]; const float* conv_b_b = (const float*)d_in[11];
    const float* conv_ln_g = (const float*)d_in[12]; const float* conv_ln_b = (const float*)d_in[13]; const float* sgu_ln_g = (const float*)d_in[14]; const float* sgu_ln_b = (const float*)d_in[15];
    const float* sgu_w = (const float*)d_in[16]; const float* sgu_b = (const float*)d_in[17]; const float* rpb = (const float*)d_in[18]; const float* group_g = (const float*)d_in[19];
    const float* w_out = (const float*)d_in[20]; const float* ffn_w1 = (const float*)d_in[21]; const float* ffn_w3 = (const float*)d_in[22]; const float* ffn_w2 = (const float*)d_in[23];
    const float* router_w = (const float*)d_in[24]; const float* router_b = (const float*)d_in[25]; const float* moe_w1 = (const float*)d_in[26]; const float* moe_w3 = (const float*)d_in[27];
    const float* moe_w2 = (const float*)d_in[28]; const float* final_g = (const float*)d_in[29];
    unsigned char* ws = (unsigned char*)d_ws;
    float* mod = (float*)(ws + WS_MOD); float* xc = (float*)(ws + WS_XC); bf16_t* H = (bf16_t*)(ws + WS_H); bf16_t* YMIX = (bf16_t*)(ws + WS_YMIX); bf16_t* P = (bf16_t*)(ws + WS_P);
    bf16_t* G = (bf16_t*)(ws + WS_G); float* YRAW = (float*)(ws + WS_YRAW); float* TMPB = (float*)(ws + WS_TMPB); float* TMPC = (float*)(ws + WS_TMPC);
    unsigned char* rt = ws + WS_ROUTE;
    int* sel_e = (int*)(rt + RT_SELE); float* sel_g = (float*)(rt + RT_SELG); int* sel_p = (int*)(rt + RT_SELP); int* slot_tok = (int*)(rt + RT_SLOTTOK); float* slot_g = (float*)(rt + RT_SLOTG); int* cnt = (int*)(rt + RT_CNT);
    float* xl = (float*)d_out;

    k_mod<<<(2 * 3 * MODW + 255) / 256, 256, 0, stream>>>(c, c_ctx, w_mod, b_mod, mod);
    for (int l = 0; l < 2; ++l) {
        const bool last = l == 1;
        const float* modl = mod + l * 3 * MODW;
        const float* xl_in = l == 0 ? x : xl; const float* xc_in = l == 0 ? ctx : xc;
        k_norm_mod<<<MT / 4, 256, 0, stream>>>(xl_in, xc_in, norm1_g + l * D, modl, 0, 1, H, 0, MT);
        { GemmArgs a{}; a.A = H; a.lda = D; a.W = w_in + (size_t)l * D * INC; a.ldw = INC; a.M = MT; a.N = INC; a.K = D; a.Cb = P; a.ldc = INC;
          k_gemm<0><<<dim3(INC / 64, MT / 64), 256, 0, stream>>>(a); }
        const int r1 = last ? MLAT : MT;
        k_mixA<<<(r1 * 256) / 256, 256, 0, stream>>>(P, conv_a_w + l * 3 * 256, YRAW, 0, r1);
        k_mixB1<<<(r1 * 256) / 256, 256, 0, stream>>>(P, conv_b_w + l * 31 * 256, conv_b_b + l * 256, TMPB, 0, r1);
        k_ln256<0><<<r1 / 4, 256, 0, stream>>>(TMPB, P, conv_ln_g + l * 256, conv_ln_b + l * 256, YRAW, 0, r1);
        k_ln256<1><<<r1 / 4, 256, 0, stream>>>(nullptr, P, sgu_ln_g + l * 256, sgu_ln_b + l * 256, TMPC, 0, r1);
        k_mixC2<<<(r1 * 256) / 256, 256, 0, stream>>>(P, TMPC, sgu_w + (size_t)l * 4 * 128 * 128, sgu_b + l * 4 * 128, YRAW, 0, r1);
        k_attn<<<r1, 256, 0, stream>>>(P, rpb + l * 4 * 15 * 31, YRAW, 0, r1);
        k_groupnorm<<<r1, 256, 0, stream>>>(YRAW, group_g + l * D, YMIX, 0, r1);
        { GemmArgs a{}; a.A = YMIX; a.lda = D; a.W = w_out + (size_t)l * D * D; a.ldw = D; a.M = r1; a.N = D; a.K = D;
          a.base_lat = xl_in; a.base_ctx = xc_in; a.out_lat = xl; a.out_ctx = xc; a.gate = modl + 2 * D;
          k_gemm<2><<<dim3(D / 64, r1 / 64), 256, 0, stream>>>(a); }
        if (!last) {
            k_norm_mod<<<MT / 4, 256, 0, stream>>>(xl, xc, norm2_g + l * D, modl, 3, 4, H, 0, MT);
            { GemmArgs a{}; a.A = H; a.lda = D; a.W = ffn_w1; a.W2 = ffn_w3; a.ldw = DFF; a.M = MT; a.N = DFF; a.K = D; a.Cb = G; a.ldc = DFF;
              k_gemm<1><<<dim3(DFF / 64, MT / 64), 256, 0, stream>>>(a); }
            { GemmArgs a{}; a.A = G; a.lda = DFF; a.W = ffn_w2; a.ldw = D; a.M = MT; a.N = D; a.K = DFF;
              a.base_lat = xl; a.base_ctx = xc; a.out_lat = xl; a.out_ctx = xc; a.gate = modl + 5 * D;
              k_gemm<2><<<dim3(D / 64, MT / 64), 256, 0, stream>>>(a); }
        } else {
            k_route<<<MLAT / 4, 256, 0, stream>>>(xl, norm2_g + l * D, modl, router_w, router_b, H, sel_e, sel_g);
            k_moe_plan<<<NEXP, 1024, 0, stream>>>(sel_e, sel_p, cnt);
            k_moe_base<<<1, 64, 0, stream>>>(cnt);
            hipMemsetAsync(slot_tok, 0xFF, (size_t)MOE_ROWS * 4, stream);
            hipMemsetAsync(slot_g, 0, (size_t)MOE_ROWS * 4, stream);
            k_moe_fill<<<MLAT * 2 / 256, 256, 0, stream>>>(sel_e, sel_g, sel_p, cnt, slot_tok, slot_g);
            float* F = YRAW;
            hipMemsetAsync(F, 0, (size_t)MLAT * D * 4, stream);
            for (int ch = 0; ch < 2; ++ch) {
                const int row0 = ch * MOE_CHUNK;
                { GemmArgs a{}; a.A = H; a.lda = D; a.gather = slot_tok; a.W = moe_w1; a.W2 = moe_w3; a.ldw = DFE; a.wstride = (size_t)D * DFE; a.ebase = cnt + 16;
                  a.M = MOE_CHUNK; a.N = DFE; a.K = D; a.row0 = row0; a.Cb = G; a.ldc = DFE; a.crow0 = row0;
                  k_gemm<1><<<dim3(DFE / 64, MOE_CHUNK / 64), 256, 0, stream>>>(a); }
                k_gemm_moe2<<<dim3(D / 64, MOE_CHUNK / 64), 256, 0, stream>>>(G, row0, moe_w2, cnt + 16, slot_tok, slot_g, F, row0, MOE_CHUNK);
            }
            k_final<<<MLAT / 4, 256, 0, stream>>>(xl, F, modl, final_g, (float*)d_out);
        }
    }
}
```

```cpp
#include <hip/hip_runtime.h>
#include <stdint.h>
#include <stdio.h>

#ifndef HYBRID
#define HYBRID 1
#endif

constexpr int D = 1024, BATCH = 2, SEQ = 16384, NCTX = 256;
constexpr int MLAT = BATCH * SEQ;
constexpr int MCTX = BATCH * NCTX;
constexpr int MT = MLAT + MCTX;
constexpr int INC = 2560;
constexpr int OFF_A = 0, OFF_B = 768, OFF_C = 1280, OFF_D = 1792, OFF_KV = 2048;
constexpr int DFF = 2816, NEXP = 8, DFE = 3584;
constexpr int GRID_W = 64, GROWS = SEQ / GRID_W;
constexpr float EPS = 1e-6f;
constexpr int MODW = 6 * D;
constexpr int PASS_ROWS = MLAT + NEXP * 256;
constexpr int NBLK = 256;
constexpr int NTHR = 512, NWAVES = 8;

typedef unsigned short bf16_t;
#define LAS __attribute__((address_space(3)))
#define GAS __attribute__((address_space(1)))
__device__ __forceinline__ float bf2f(bf16_t u) { return __uint_as_float(((unsigned)u) << 16); }
__device__ __forceinline__ bf16_t f2bf(float f) { unsigned u = __float_as_uint(f); return (bf16_t)((u + 0x7fffu + ((u >> 16) & 1u)) >> 16); }
__device__ __forceinline__ unsigned pk2(float lo, float hi) { return (unsigned)f2bf(lo) | ((unsigned)f2bf(hi) << 16); }
__device__ __forceinline__ float wave_sum(float v) {
#pragma unroll
    for (int o = 1; o < 64; o <<= 1) v += __shfl_xor(v, o);
    return v;
}
__device__ __forceinline__ float wave_max(float v) {
#pragma unroll
    for (int o = 1; o < 64; o <<= 1) v = fmaxf(v, __shfl_xor(v, o));
    return v;
}
__device__ __forceinline__ float silu_f(float x) { return x / (1.f + __expf(-x)); }
__device__ __forceinline__ float sigmoid_f(float x) { return 1.f / (1.f + __expf(-x)); }
__device__ __forceinline__ float gelu_tanh_f(float x) { const float u = 0.7978845608028654f * (x + 0.044715f * x * x * x); return 0.5f * x * (1.f + tanhf(u)); }
__device__ __forceinline__ int row_modset(int r) { return r < MLAT ? r / SEQ : 2; }
__device__ __forceinline__ void row_seq(int r, int& s0, int& len) {
    if (r < MLAT) { s0 = (r / SEQ) * SEQ; len = SEQ; } else { s0 = MLAT + ((r - MLAT) / NCTX) * NCTX; len = NCTX; }
}

constexpr size_t MiB = 1ull << 20;
constexpr size_t WS_CTL = 0, CTL_ZERO_BYTES = 1 * MiB;
constexpr size_t WS_MOD = 1 * MiB;
constexpr size_t WS_XC = 2 * MiB;
constexpr size_t WS_SEL = 4 * MiB;
constexpr size_t WS_SLOT = 5 * MiB;
constexpr size_t WS_SGUW = 6 * MiB;
constexpr size_t WS_BIAS = 7 * MiB;
constexpr size_t WS_H = 8 * MiB;
constexpr size_t WS_P = 74 * MiB;
constexpr size_t WS_G = 74 * MiB;
constexpr size_t WS_YMIX = 240 * MiB;
constexpr size_t WS_WIN = 312 * MiB;
constexpr size_t WS_WOUT = 322 * MiB;
constexpr size_t WS_W13 = 326 * MiB;
constexpr size_t WS_W2 = 337 * MiB;
constexpr size_t WS_MW13 = 344 * MiB;
constexpr size_t WS_MW2 = 456 * MiB;
constexpr size_t WS_END = 512 * MiB;
constexpr size_t WS_YRAW = 344 * MiB;
constexpr size_t WS_TMP = 474 * MiB;
static_assert(WS_G + (size_t)PASS_ROWS * DFE * 2 <= WS_WIN && WS_YMIX + (size_t)MT * D * 2 <= WS_WIN && WS_P + (size_t)MT * INC * 2 <= WS_YMIX, "ws map");
static_assert(WS_TMP + (size_t)MT * 256 * 4 <= WS_END, "ws map hybrid");
constexpr size_t SEL_E = 0, SEL_G = (size_t)MLAT * 2 * 4, SEL_R = (size_t)MLAT * 4 * 4;
constexpr size_t SLOT_TOK = 0, SLOT_GATE = (size_t)2 * PASS_ROWS * 4, SLOT_HIST = (size_t)4 * PASS_ROWS * 4, SLOT_EBASE = SLOT_HIST + 256 * 16 * 4;
static_assert(SEL_R + (size_t)MLAT * 2 * 4 <= 1 * MiB && SLOT_EBASE + 256 <= 1 * MiB, "route map");
constexpr int CW_BAR = 4096;

constexpr int RING_BYTES = 131072;
constexpr int GTAB_OFF = RING_BYTES, GTAB_BYTES = 16384;
constexpr int MISC_OFF = GTAB_OFF + GTAB_BYTES;
constexpr int LDS_BYTES = MISC_OFF + 512;
#if HYBRID
__global__ void k_mixA(const bf16_t* __restrict__ P, const float* __restrict__ wA  , float* __restrict__ YRAW, int r0, int r1) {
    const int idx = blockIdx.x * 256 + threadIdx.x; const int row = r0 + idx / 256, ch = idx % 256;
    if (row >= r1) return;
    int s0, len; row_seq(row, s0, len); const int t = row - s0;
    float acc = 0.f;
    for (int j = 0; j < 3; ++j) { const int tt = t + j - 1; if (tt < 0 || tt >= len) continue;
        const bf16_t* pr = P + (size_t)(s0 + tt) * INC + OFF_A; acc += wA[j * 256 + ch] * (bf2f(pr[256 + ch]) * bf2f(pr[512 + ch])); }
    YRAW[(size_t)row * D + ch] = bf2f(P[(size_t)row * INC + OFF_A + ch]) * acc;
}
__global__ void k_mixB1(const bf16_t* __restrict__ P, const float* __restrict__ wB  , const float* __restrict__ bB, float* __restrict__ TMP, int r0, int r1) {
    const int idx = blockIdx.x * 256 + threadIdx.x; const int row = r0 + idx / 256, ch = idx % 256;
    if (row >= r1) return;
    int s0, len; row_seq(row, s0, len); const int t = row - s0;
    float acc = bB[ch];
    for (int j = 0; j < 31; ++j) { const int tt = t + j - 15; if (tt < 0 || tt >= len) continue;
        const bf16_t* pr = P + (size_t)(s0 + tt) * INC + OFF_B; acc += wB[j * 256 + ch] * (bf2f(pr[ch]) * sigmoid_f(bf2f(pr[256 + ch]))); }
    TMP[(size_t)row * 256 + ch] = acc;
}
template <int MODE> __global__ void k_ln256(const float* __restrict__ TMPin, const bf16_t* __restrict__ P, const float* __restrict__ g, const float* __restrict__ b, float* __restrict__ dst, int r0, int r1) {
    const int lane = threadIdx.x & 63; const int row = r0 + blockIdx.x * 4 + (threadIdx.x >> 6);
    if (row >= r1) return;
    float v[4];
#pragma unroll
    for (int i = 0; i < 4; ++i) { const int ch = lane * 4 + i; v[i] = MODE == 0 ? TMPin[(size_t)row * 256 + ch] : gelu_tanh_f(bf2f(P[(size_t)row * INC + OFF_C + 256 + ch])); }
    const float mu = wave_sum(v[0] + v[1] + v[2] + v[3]) * (1.f / 256.f);
    float q = 0.f;
#pragma unroll
    for (int i = 0; i < 4; ++i) { v[i] -= mu; q += v[i] * v[i]; }
    const float rstd = rsqrtf(wave_sum(q) * (1.f / 256.f) + EPS);
#pragma unroll
    for (int i = 0; i < 4; ++i) { const int ch = lane * 4 + i; const float y = v[i] * rstd * g[ch] + b[ch];
        if (MODE == 0) dst[(size_t)row * D + 256 + ch] = silu_f(y); else dst[(size_t)row * 256 + ch] = y; }
}
__global__ void k_mixC2(const bf16_t* __restrict__ P, const float* __restrict__ VN  , const float* __restrict__ ws  , const float* __restrict__ bs  , float* __restrict__ YRAW, int r0, int r1) {
    const int idx = blockIdx.x * 256 + threadIdx.x; const int row = r0 + idx / 256, ch = idx % 256;
    if (row >= r1) return;
    int s0, len; row_seq(row, s0, len); const int t = row - s0; const int cb = s0 + (t / 128) * 128, pl = t % 128, h = ch / 64;
    float acc = bs[h * 128 + pl];
    const float* wr = ws + ((size_t)h * 128 + pl) * 128;
    for (int q = 0; q < 128; ++q) acc += wr[q] * VN[(size_t)(cb + q) * 256 + ch];
    YRAW[(size_t)row * D + 512 + ch] = gelu_tanh_f(bf2f(P[(size_t)row * INC + OFF_C + ch])) * acc;
}
__global__ __launch_bounds__(256) void k_attn(const bf16_t* __restrict__ P, const float* __restrict__ rpb  , float* __restrict__ YRAW, int r0, int r1) {
    __shared__ float sc[4][384];
    const int lane = threadIdx.x & 63, w = threadIdx.x >> 6;
    const int item = blockIdx.x * 4 + w; const int row = r0 + item / 4, h = item % 4;
    if (row >= r1) return;
    const bool lat = row < MLAT;
    const int b = lat ? row / SEQ : (row - MLAT) / NCTX;
    const int t = lat ? row % SEQ : 0, gr = t / GRID_W, gc = t % GRID_W;
    const int kr0 = min(max(gr - 4, 0), GROWS - 8), c0 = min(max(gc - 8, 0), GRID_W - 16);
    const int nloc = lat ? 128 : 0, nk = nloc + NCTX;
    const float q = bf2f(P[(size_t)row * INC + OFF_D + h * 64 + lane]) * 0.125f;
    float* s = sc[w];
    for (int i = 0; i < nk; ++i) {
        int krow; float bias = 0.f;
        if (i < nloc) { const int kr = kr0 + i / 16, kc = c0 + i % 16; krow = b * SEQ + kr * GRID_W + kc; bias = rpb[(h * 15 + (kr - gr + 7)) * 31 + (kc - gc + 15)]; }
        else krow = MLAT + b * NCTX + (i - nloc);
        const float d = wave_sum(q * bf2f(P[(size_t)krow * INC + OFF_KV + h * 64 + lane])) + bias;
        if (lane == 0) s[i] = d;
    }
    __syncthreads();
    float m = -1e30f;
    for (int i = lane; i < nk; i += 64) m = fmaxf(m, s[i]);
    m = wave_max(m);
    float sum = 0.f;
    for (int i = lane; i < nk; i += 64) { const float e = __expf(s[i] - m); s[i] = e; sum += e; }
    sum = wave_sum(sum);
    __syncthreads();
    float o = 0.f;
    for (int i = 0; i < nk; ++i) {
        int krow;
        if (i < nloc) { const int kr = kr0 + i / 16, kc = c0 + i % 16; krow = b * SEQ + kr * GRID_W + kc; }
        else krow = MLAT + b * NCTX + (i - nloc);
        o += s[i] * bf2f(P[(size_t)krow * INC + OFF_KV + 256 + h * 64 + lane]);
    }
    YRAW[(size_t)row * D + 768 + h * 64 + lane] = o / sum;
}
__global__ void k_groupnorm(const float* __restrict__ YRAW, const float* __restrict__ gg  , bf16_t* __restrict__ YMIX, int r0, int r1) {
    const int lane = threadIdx.x & 63; const int item = blockIdx.x * 4 + (threadIdx.x >> 6); const int row = r0 + item / 4, g = item % 4;
    if (row >= r1) return;
    const float4 v = *(const float4*)(YRAW + (size_t)row * D + g * 256 + lane * 4);
    const float rstd = rsqrtf(wave_sum(v.x * v.x + v.y * v.y + v.z * v.z + v.w * v.w) * (1.f / 256.f) + EPS);
    const float4 w = *(const float4*)(gg + g * 256 + lane * 4);
    ushort4 o; o.x = f2bf(v.x * rstd * w.x); o.y = f2bf(v.y * rstd * w.y); o.z = f2bf(v.z * rstd * w.z); o.w = f2bf(v.w * rstd * w.w);
    *(ushort4*)(YMIX + (size_t)row * D + g * 256 + lane * 4) = o;
}

#endif

namespace pg8 {
typedef short bf16x8 __attribute__((ext_vector_type(8)));
typedef float f32x4 __attribute__((ext_vector_type(4)));
typedef unsigned u32x4 __attribute__((ext_vector_type(4)));
constexpr int BM = 256, BK = 64, HALF = 128, HTB = HALF * BK * 2  , STAGE_BYTES = 8 * HTB, NXCD = 8, WGM = 8;

__host__ __device__ __forceinline__ int lds_byte(int r, int c) { const int st = (r >> 4) * 2 + (c >> 5), rr = r & 15, cc = c & 31, ob = rr * 64 + cc * 2; return st * 1024 + (ob ^ (((ob >> 9) & 1) << 5)); }
__host__ __device__ __forceinline__ void stage_rc(int b, int& R, int& C) { const int st = b / 1024, sb = b % 1024, swz = sb ^ (((sb >> 9) & 1) << 5); R = (st >> 1) * 16 + swz / 64; C = (st & 1) * 32 + (swz % 64) / 2; }
__host__ __device__ __forceinline__ int perm32(int rho) { const int n = rho >> 4, i = rho & 15; return 8 * (i >> 2) + 4 * n + (i & 3); }

struct Unit { int pm, pn, e; };
struct Gemm { const bf16_t* A; const bf16_t* Bt; size_t bstride; int M, N, K; };

struct StaticOrder {
    int nM, nN, nwg, G, c;
    __host__ __device__ void init(int M, int N, int G_, int c_) { nM = M / BM; nN = N / BM; nwg = nM * nN; G = G_; c = c_; }
    __host__ __device__ bool next(int i, Unit& u) const {
        const long L = (long)i * G + c; if (L >= nwg) return false;
        int wgid = (int)L; { const int q = nwg / NXCD, r = nwg % NXCD, xcd = wgid % NXCD, off = wgid / NXCD; wgid = (xcd < r ? xcd * (q + 1) : r * (q + 1) + (xcd - r) * q) + off; }
        const int nig = WGM * nN, gid = wgid / nig, fm = gid * WGM, gsz = (nM - fm) < WGM ? (nM - fm) : WGM;
        u.pm = fm + ((wgid % nig) % gsz); u.pn = (wgid % nig) / gsz; u.e = 0; return true;
    }
};
struct GroupedOrder {
    StaticOrder so; int et[9];
    __device__ void init(const int* ebase_rows, int N, int G_, int c_) {
#pragma unroll
        for (int i = 0; i < 9; ++i) et[i] = __builtin_amdgcn_readfirstlane(ebase_rows[i]) / BM;
        so.init(et[8] * BM, N, G_, c_);
    }
    __device__ bool next(int i, Unit& u) const {
        if (!so.next(i, u)) return false;
        int e = 0;
#pragma unroll
        for (int k = 1; k < 8; ++k) e += (u.pm >= et[k]) ? 1 : 0;
        u.e = e; return true;
    }
};

__device__ __forceinline__ unsigned cvt_pk_bf16(float lo, float hi) { unsigned r; asm volatile("v_cvt_pk_bf16_f32 %0, %1, %2" : "=v"(r) : "v"(lo), "v"(hi)); return r; }

struct EpiStoreBf16 {
    static constexpr bool PERM = true;
    bf16_t* O; int ldc;
    __device__ __forceinline__ void operator()(const f32x4 (&acc)[2][2][4][2], const Unit& u, int wr, int wc, int fr, int fq) const {
        const int row0 = u.pm * BM + wr * 64 + fr, col0 = u.pn * BM + wc * 32 + 8 * fq;
#pragma unroll
        for (int ai = 0; ai < 2; ++ai)
#pragma unroll
            for (int m = 0; m < 4; ++m) { bf16_t* rowp = O + (size_t)(row0 + ai * HALF + m * 16) * ldc + col0;
#pragma unroll
                for (int bj = 0; bj < 2; ++bj) { const f32x4 v0 = acc[ai][bj][m][0], v1 = acc[ai][bj][m][1];
                    u32x4 w; w.x = cvt_pk_bf16(v0[0], v0[1]); w.y = cvt_pk_bf16(v0[2], v0[3]); w.z = cvt_pk_bf16(v1[0], v1[1]); w.w = cvt_pk_bf16(v1[2], v1[3]);
                    *(u32x4*)(rowp + bj * HALF) = w; } }
    }
};
__device__ __forceinline__ float silu_fast(float x) { return x * __builtin_amdgcn_rcpf(1.f + __builtin_amdgcn_exp2f(-1.4426950408889634f * x)); }
struct EpiSwiglu {
    static constexpr bool PERM = true;
    bf16_t* G; int ldg;
    __device__ __forceinline__ void operator()(const f32x4 (&acc)[2][2][4][2], const Unit& u, int wr, int wc, int fr, int fq) const {
        const int row0 = u.pm * BM + wr * 64 + fr, col0 = u.pn * HALF + wc * 32 + 8 * fq;
#pragma unroll
        for (int ai = 0; ai < 2; ++ai)
#pragma unroll
            for (int m = 0; m < 4; ++m) {
                const f32x4 a0 = acc[ai][0][m][0], a1 = acc[ai][0][m][1], b0 = acc[ai][1][m][0], b1 = acc[ai][1][m][1];
                u32x4 w;
                w.x = cvt_pk_bf16(silu_fast(a0[0]) * b0[0], silu_fast(a0[1]) * b0[1]); w.y = cvt_pk_bf16(silu_fast(a0[2]) * b0[2], silu_fast(a0[3]) * b0[3]);
                w.z = cvt_pk_bf16(silu_fast(a1[0]) * b1[0], silu_fast(a1[1]) * b1[1]); w.w = cvt_pk_bf16(silu_fast(a1[2]) * b1[2], silu_fast(a1[3]) * b1[3]);
                *(u32x4*)(G + (size_t)(row0 + ai * HALF + m * 16) * ldg + col0) = w; }
    }
};
struct EpiResid {
    static constexpr bool PERM = false;
    const float* base_lat; const float* base_ctx; float* out_lat; float* out_ctx; const float* gate;
    __device__ __forceinline__ void operator()(const f32x4 (&acc)[2][2][4][2], const Unit& u, int wr, int wc, int fr, int fq) const {
        const bool lat = u.pm < MLAT / BM;
        const int set = lat ? (u.pm >= SEQ / BM ? 1 : 0) : 2 + 0 * u.pm;
        const float* gt = gate + (lat ? set : 2) * MODW;
        const float* bs = lat ? base_lat : base_ctx; float* op = lat ? out_lat : out_ctx;
        const int row0 = (lat ? u.pm * BM : (u.pm - MLAT / BM) * BM) + wr * 64 + fr, col0 = u.pn * BM + wc * 32 + 4 * fq;
        f32x4 gv[2][2];
#pragma unroll
        for (int bj = 0; bj < 2; ++bj)
#pragma unroll
            for (int n = 0; n < 2; ++n) gv[bj][n] = *(const f32x4*)(gt + col0 + bj * HALF + n * 16);
#pragma unroll
        for (int ai = 0; ai < 2; ++ai)
#pragma unroll
            for (int m = 0; m < 4; ++m) { const size_t off = (size_t)(row0 + ai * HALF + m * 16) * D + col0;
#pragma unroll
                for (int bj = 0; bj < 2; ++bj)
#pragma unroll
                    for (int n = 0; n < 2; ++n) { const f32x4 b = *(const f32x4*)(bs + off + bj * HALF + n * 16);
                        *(f32x4*)(op + off + bj * HALF + n * 16) = b + gv[bj][n] * acc[ai][bj][m][n]; } }
    }
};
struct EpiMoeDown {
    static constexpr bool PERM = false;
    float* xl; const int* slot_tok; const float* slot_gate; const float* g2;
    __device__ __forceinline__ void operator()(const f32x4 (&acc)[2][2][4][2], const Unit& u, int wr, int wc, int fr, int fq) const {
        const int row0 = u.pm * BM + wr * 64 + fr, col0 = u.pn * BM + wc * 32 + 4 * fq;
#pragma unroll
        for (int ai = 0; ai < 2; ++ai)
#pragma unroll
            for (int m = 0; m < 4; ++m) { const int slot = row0 + ai * HALF + m * 16; const int tok = slot_tok[slot];
                if (tok < 0) continue;
                const float sg = slot_gate[slot]; const float* gt = g2 + (tok >= SEQ ? MODW : 0) + col0; float* xp = xl + (size_t)tok * D + col0;
#pragma unroll
                for (int bj = 0; bj < 2; ++bj)
#pragma unroll
                    for (int n = 0; n < 2; ++n) { const f32x4 gq = *(const f32x4*)(gt + bj * HALF + n * 16); const f32x4 b = *(const f32x4*)(xp + bj * HALF + n * 16);
                        *(f32x4*)(xp + bj * HALF + n * 16) = b + (gq * sg) * acc[ai][bj][m][n]; } }
    }
};

template <class Epi, class Sched, bool GATHER>
__device__ __forceinline__ void gemm_phase(LAS unsigned char* lds, const LAS unsigned* gtab, const Gemm g, const Sched& S, const Epi& E, const int tid) {
    const int wid = __builtin_amdgcn_readfirstlane(tid >> 6), lane = tid & 63, wr = wid >> 2, wc = wid & 3, fr = lane & 15, fq = lane >> 4;
    const int K = g.K, nt = K / BK;
    const size_t kstep = (size_t)(BK * 2);
    const size_t hstep = (size_t)HALF * K * 2;
    const size_t tstep = 2 * hstep;
    unsigned voffB[2], ga[2][2], gan[2][2]; int RA[2]; unsigned CA2[2];
#pragma unroll
    for (int i = 0; i < 2; ++i) { int R, C; stage_rc(tid * 16 + i * 8192, R, C); const int Rb = Epi::PERM ? ((R & ~31) + perm32(R & 31)) : R;
        voffB[i] = (unsigned)(Rb * K + C) * 2u; RA[i] = R; CA2[i] = (unsigned)C * 2u;
        if (!GATHER) { ga[0][i] = (unsigned)(R * K + C) * 2u; ga[1][i] = ga[0][i] + (unsigned)hstep; gan[0][i] = ga[0][i]; gan[1][i] = ga[1][i]; } }
    const unsigned ldsw = (unsigned)wid * 1024u;
    const int aoff = lds_byte(wr * 64 + fr, fq * 8), boff = lds_byte(wc * 32 + fr, fq * 8);
#define PG8_SA(b, h) (((b) * 2 + (h)) * HTB)
#define PG8_SB(b, h) ((4 + (b) * 2 + (h)) * HTB)
#define PG8_STAGE(bufoff, gbase, voff) do { _Pragma("unroll") for (int _i = 0; _i < 2; ++_i) \
        __builtin_amdgcn_global_load_lds((const unsigned*)((const char*)(gbase) + (voff)[_i]), (LAS unsigned*)(lds + (bufoff) + ldsw + _i * 8192), 16, 0, 0); } while (0)
#define PG8_LDA(dst, b, h) do { _Pragma("unroll") for (int m = 0; m < 4; ++m) _Pragma("unroll") for (int k = 0; k < 2; ++k) dst[m][k] = *(const LAS bf16x8*)(lds + PG8_SA(b, h) + aoff + m * 2048 + k * 1024); } while (0)
#define PG8_LDB(dst, b, h) do { _Pragma("unroll") for (int n = 0; n < 2; ++n) _Pragma("unroll") for (int k = 0; k < 2; ++k) dst[n][k] = *(const LAS bf16x8*)(lds + PG8_SB(b, h) + boff + n * 2048 + k * 1024); } while (0)
#define PG8_MMA(ai, bj, At, Bt) do { __builtin_amdgcn_s_setprio(1); _Pragma("unroll") for (int m = 0; m < 4; ++m) _Pragma("unroll") for (int n = 0; n < 2; ++n) _Pragma("unroll") for (int k = 0; k < 2; ++k) \
        acc[ai][bj][m][n] = __builtin_amdgcn_mfma_f32_16x16x32_bf16(Bt[n][k], At[m][k], acc[ai][bj][m][n], 0, 0, 0); __builtin_amdgcn_s_setprio(0); } while (0)
#define PG8_WAIT_V(n) asm volatile("s_waitcnt vmcnt(" #n ")" ::: "memory")
#define PG8_WAIT_L(n) asm volatile("s_waitcnt lgkmcnt(" #n ")" ::: "memory")
#define PG8_BAR __builtin_amdgcn_s_barrier()
#define PG8_SCHED __builtin_amdgcn_sched_barrier(0)
#define PG8_GLOAD(dst, ui_) do { _Pragma("unroll") for (int _h = 0; _h < 2; ++_h) _Pragma("unroll") for (int _i = 0; _i < 2; ++_i) dst[_h][_i] = gtab[(ui_) * 256 + _h * HALF + RA[_i]] + CA2[_i]; } while (0)
    Unit cur, nxt; int ui = 0;
    if (!S.next(0, cur)) return;
    f32x4 acc[2][2][4][2];
#pragma unroll
    for (int a = 0; a < 2; ++a)
#pragma unroll
        for (int b = 0; b < 2; ++b)
#pragma unroll
            for (int m = 0; m < 4; ++m)
#pragma unroll
                for (int n = 0; n < 2; ++n) acc[a][b][m][n] = (f32x4){0.f, 0.f, 0.f, 0.f};
    bf16x8 At[4][2], B0[2][2], B1[2][2];
    const char* cA = (const char*)g.A + (GATHER ? (size_t)0 : (size_t)cur.pm * tstep);
    const char* cB = (const char*)g.Bt + (size_t)cur.e * g.bstride + (size_t)cur.pn * tstep;
    if (GATHER) PG8_GLOAD(ga, 0);
    PG8_STAGE(PG8_SB(0, 0), cB, voffB); PG8_STAGE(PG8_SB(0, 1), cB + hstep, voffB); PG8_STAGE(PG8_SA(0, 0), cA, ga[0]); PG8_STAGE(PG8_SA(0, 1), cA, ga[1]);
    if (wr == 1) PG8_BAR;
    PG8_WAIT_V(2); PG8_BAR;
    PG8_STAGE(PG8_SB(1, 0), cB + kstep, voffB); PG8_STAGE(PG8_SA(1, 0), cA + kstep, ga[0]); PG8_STAGE(PG8_SB(1, 1), cB + hstep + kstep, voffB);
    PG8_WAIT_V(6); PG8_BAR;
    for (;;) {
        const bool has_next = S.next(ui + 1, nxt);
        const char* nA = has_next ? (const char*)g.A + (GATHER ? (size_t)0 : (size_t)nxt.pm * tstep) : cA;
        const char* nB = has_next ? (const char*)g.Bt + (size_t)nxt.e * g.bstride + (size_t)nxt.pn * tstep : cB;
        if (GATHER) { if (has_next) PG8_GLOAD(gan, ui + 1); else { _Pragma("unroll") for (int h = 0; h < 2; ++h) _Pragma("unroll") for (int i = 0; i < 2; ++i) gan[h][i] = ga[h][i]; } }
        for (int t = 0; t < nt; t += 2) {
            const bool last = (t == nt - 2);
            const char* a1 = cA + (size_t)(t + 1) * kstep;
            const char* a2 = last ? nA : cA + (size_t)(t + 2) * kstep; const char* b2 = last ? nB : cB + (size_t)(t + 2) * kstep;
            const char* a3 = a2 + kstep; const char* b3 = b2 + kstep;
            unsigned s2[2][2];
#pragma unroll
            for (int h = 0; h < 2; ++h)
#pragma unroll
                for (int i = 0; i < 2; ++i) s2[h][i] = (GATHER && last) ? gan[h][i] : ga[h][i];
            PG8_LDB(B0, 0, 0); PG8_LDB(B1, 0, 1); PG8_SCHED; PG8_LDA(At, 0, 0); PG8_STAGE(PG8_SA(1, 1), a1, ga[1]);
            PG8_WAIT_V(8); PG8_WAIT_L(0); PG8_BAR; PG8_MMA(0, 0, At, B0); PG8_MMA(0, 1, At, B1); PG8_BAR; PG8_SCHED;
            PG8_LDA(At, 0, 1); PG8_STAGE(PG8_SB(0, 0), b2, voffB); PG8_STAGE(PG8_SB(0, 1), b2 + hstep, voffB); PG8_STAGE(PG8_SA(0, 0), a2, s2[0]);
            PG8_WAIT_V(8); PG8_WAIT_L(0); PG8_BAR; PG8_MMA(1, 0, At, B0); PG8_MMA(1, 1, At, B1); PG8_BAR; PG8_SCHED;
            PG8_LDB(B0, 1, 0); PG8_LDB(B1, 1, 1); PG8_SCHED; PG8_LDA(At, 1, 0); PG8_STAGE(PG8_SA(0, 1), a2, s2[1]);
            PG8_WAIT_V(8); PG8_WAIT_L(0); PG8_BAR; PG8_MMA(0, 0, At, B0); PG8_MMA(0, 1, At, B1); PG8_BAR; PG8_SCHED;
            PG8_LDA(At, 1, 1); PG8_STAGE(PG8_SB(1, 0), b3, voffB); PG8_STAGE(PG8_SB(1, 1), b3 + hstep, voffB); PG8_STAGE(PG8_SA(1, 0), a3, s2[0]);
            PG8_WAIT_V(8); PG8_WAIT_L(0); PG8_BAR; PG8_MMA(1, 0, At, B0); PG8_MMA(1, 1, At, B1); PG8_BAR; PG8_SCHED;
        }
        if (wr == 0) PG8_BAR;
        E(acc, cur, wr, wc, fr, fq);
        if (!has_next) break;
#pragma unroll
        for (int a = 0; a < 2; ++a)
#pragma unroll
            for (int b = 0; b < 2; ++b)
#pragma unroll
                for (int m = 0; m < 4; ++m)
#pragma unroll
                    for (int n = 0; n < 2; ++n) acc[a][b][m][n] = (f32x4){0.f, 0.f, 0.f, 0.f};
        cur = nxt; cA = nA; cB = nB; ++ui;
#pragma unroll
        for (int h = 0; h < 2; ++h)
#pragma unroll
            for (int i = 0; i < 2; ++i) ga[h][i] = gan[h][i];
        if (wr == 1) PG8_BAR;
    }
    PG8_WAIT_V(0);
    PG8_BAR;
#undef PG8_SA
#undef PG8_SB
#undef PG8_STAGE
#undef PG8_LDA
#undef PG8_LDB
#undef PG8_MMA
#undef PG8_WAIT_V
#undef PG8_WAIT_L
#undef PG8_BAR
#undef PG8_SCHED
#undef PG8_GLOAD
}
}

#define XB_TMO      128
#define XB_XCNT(j)  (256  + 64 * (j))
#define XB_XSUB(j)  (1280 + 64 * (j))
#define XB_XGEN(j)  (2304 + 64 * (j))
#define XB_TOP      3328
#define XB_TOPGEN   3392
#define XCD_BAR_WORDS 3456
#define XB_SPIN_CAP (1u << 18)

__device__ __forceinline__ unsigned xb_ld(unsigned* p)              { return __hip_atomic_load(p, __ATOMIC_RELAXED, __HIP_MEMORY_SCOPE_AGENT); }
__device__ __forceinline__ unsigned xb_add(unsigned* p, unsigned v) { return __hip_atomic_fetch_add(p, v, __ATOMIC_RELAXED, __HIP_MEMORY_SCOPE_AGENT); }
__device__ __forceinline__ unsigned xb_xcc_id() { return (unsigned)__builtin_amdgcn_s_getreg((3 << 11) | 20) & 0xFu; }
#define XB_SPIN(cond, bar) do { unsigned _sp = 0; while (cond) { __builtin_amdgcn_s_sleep(1); \
    if ((++_sp & 255u) == 0u) { if (xb_ld(&(bar)[XB_TMO])) break; if (_sp > XB_SPIN_CAP) { atomicAdd(&(bar)[XB_TMO], 1u); break; } } } } while (0)

struct XcdBarrier {
    unsigned* bar; unsigned x;
    volatile LAS unsigned* st;
};
__device__ __forceinline__ XcdBarrier xcd_barrier_post(unsigned* bar, volatile LAS unsigned* st) {
    XcdBarrier b; b.bar = bar; b.x = xb_xcc_id(); b.st = st;
    if (threadIdx.x == 0) (void)xb_add(&bar[XB_XCNT(b.x)], 1u);
    return b;
}
__device__ __forceinline__ void xcd_barrier_complete(unsigned* bar, unsigned x, unsigned& nloc, unsigned& nx) {
    const unsigned G = gridDim.x * gridDim.y * gridDim.z;
    unsigned sum, cnt, mine, sp = 0u;
    for (;;) {
        sum = 0u; cnt = 0u; mine = 0u;
#pragma unroll
        for (unsigned j = 0; j < 16; ++j) { const unsigned c = xb_ld(&bar[XB_XCNT(j)]); sum += c; cnt += (c > 0u) ? 1u : 0u; mine = (j == x) ? c : mine; }
        if (sum == G) break;
        __builtin_amdgcn_s_sleep(1);
        if ((++sp & 255u) == 0u) { if (xb_ld(&bar[XB_TMO])) break; if (sp > XB_SPIN_CAP) { atomicAdd(&bar[XB_TMO], 1u); break; } }
    }
    nloc = mine > 0u ? mine : 1u; nx = cnt > 0u ? cnt : 1u;
}
__device__ __forceinline__ void xcd_barrier(const XcdBarrier& b) {
    asm volatile("s_waitcnt vmcnt(0)" ::: "memory");
    __syncthreads();
    if (threadIdx.x == 0) {
        unsigned* bar = b.bar;
        __builtin_amdgcn_s_waitcnt(0);
        unsigned nloc = b.st[0], nx = b.st[1];
        if (nloc == 0u) { xcd_barrier_complete(bar, b.x, nloc, nx); b.st[0] = nloc; b.st[1] = nx; }
        const unsigned old = xb_add(&bar[XB_XSUB(b.x)], 1u);
        const unsigned gen = old / nloc;
        if (old + 1u == (gen + 1u) * nloc) {
            __builtin_amdgcn_fence(__ATOMIC_RELEASE, "agent");
            asm volatile("s_waitcnt vmcnt(0)" ::: "memory");
            const unsigned og = xb_add(&bar[XB_TOP], 1u);
            const unsigned tg = og / nx;
            if (og + 1u == (tg + 1u) * nx) xb_add(&bar[XB_TOPGEN], 1u);
            else XB_SPIN(xb_ld(&bar[XB_TOPGEN]) == tg, bar);
            __builtin_amdgcn_fence(__ATOMIC_ACQUIRE, "agent");
            xb_add(&bar[XB_XGEN(b.x)], 1u);
            asm volatile("s_waitcnt vmcnt(0)" ::: "memory");
        } else {
            XB_SPIN(xb_ld(&bar[XB_XGEN(b.x)]) == gen, bar);
            __builtin_amdgcn_fence(__ATOMIC_ACQUIRE, "agent");
            asm volatile("s_waitcnt vmcnt(0)" ::: "memory");
        }
    }
    __syncthreads();
}

typedef float f32x4v __attribute__((ext_vector_type(4)));
typedef unsigned u32x4v __attribute__((ext_vector_type(4)));

__device__ __forceinline__ void tr_item(const float* __restrict__ W, int ldn, int k0, int n0, bf16_t* __restrict__ WT, int ldk, int drow0, LAS float* scr, int lane) {
#pragma unroll 8
    for (int i = 0; i < 32; ++i) { const int kk = 2 * i + (lane >> 5); scr[kk * 33 + (lane & 31)] = W[(size_t)(k0 + kk) * ldn + n0 + (lane & 31)]; }
    asm volatile("s_waitcnt lgkmcnt(0)" ::: "memory");
    const int c = lane & 7;
#pragma unroll
    for (int j = 0; j < 4; ++j) { const int n = (lane >> 3) + 8 * j; const LAS float* s = scr + (8 * c) * 33 + n;
        u32x4v o; o.x = pk2(s[0 * 33], s[1 * 33]); o.y = pk2(s[2 * 33], s[3 * 33]); o.z = pk2(s[4 * 33], s[5 * 33]); o.w = pk2(s[6 * 33], s[7 * 33]);
        *(u32x4v*)(WT + (size_t)(drow0 + n) * ldk + k0 + 8 * c) = o; }
    asm volatile("s_waitcnt lgkmcnt(0)" ::: "memory");
}
struct KArgs {
    const float* in[30]; float* out; unsigned char* ws;
    int ph_lo, ph_hi, li, flags;
};
enum { IN_X = 0, IN_C, IN_CTX, IN_CCTX, IN_WMOD, IN_BMOD, IN_N1G, IN_N2G, IN_WIN, IN_CAW, IN_CBW, IN_CBB, IN_CLG, IN_CLB, IN_SLG, IN_SLB, IN_SGW, IN_SGB, IN_RPB, IN_GG, IN_WOUT,
       IN_FW1, IN_FW3, IN_FW2, IN_RW, IN_RB, IN_MW1, IN_MW3, IN_MW2, IN_FG };
enum { PH_PRO = 0, PH_N1_0, PH_G1_0, PH_MIX_0, PH_G2_0, PH_N2_0, PH_F1_0, PH_F2_0, PH_N1_1, PH_G1_1, PH_MIX_1, PH_MOECONV, PH_G2_1, PH_RT, PH_PLAN, PH_M1A, PH_M2A, PH_M1B, PH_M2B, PH_FIN, PH_COUNT };

constexpr int IT_WIN = 2 * 16 * 80, IT_WOUT = 2 * 16 * 32, IT_F1 = 16 * 88, IT_F2 = 44 * 32, IT_DENSE = IT_WIN + IT_WOUT + 2 * IT_F1 + IT_F2;
constexpr int IT_M1 = 16 * 112, IT_M2 = 56 * 32, IT_ME = 2 * IT_M1 + IT_M2, IT_MOE = NEXP * IT_ME;
__device__ __forceinline__ void conv_item(const KArgs& a, unsigned char* ws, int it, LAS float* scr, int lane) {
    if (it < IT_WIN) { const int l = it / 1280, r = it % 1280, kb = r / 80, nb = r % 80;
        tr_item(a.in[IN_WIN] + (size_t)l * D * INC, INC, kb * 64, nb * 32, (bf16_t*)(ws + WS_WIN) + (size_t)l * INC * D, D, nb * 32, scr, lane); return; }
    it -= IT_WIN;
    if (it < IT_WOUT) { const int l = it / 512, r = it % 512, kb = r / 32, nb = r % 32;
        tr_item(a.in[IN_WOUT] + (size_t)l * D * D, D, kb * 64, nb * 32, (bf16_t*)(ws + WS_WOUT) + (size_t)l * D * D, D, nb * 32, scr, lane); return; }
    it -= IT_WOUT;
    if (it < 2 * IT_F1) { const int w3 = it / IT_F1, r = it % IT_F1, kb = r / 88, nb = r % 88, n0 = nb * 32;
        tr_item((w3 ? a.in[IN_FW3] : a.in[IN_FW1]), DFF, kb * 64, n0, (bf16_t*)(ws + WS_W13), D, (n0 / 128) * 256 + (n0 % 128) + w3 * 128, scr, lane); return; }
    it -= 2 * IT_F1;
    if (it < IT_F2) { const int kb = it / 32, nb = it % 32;
        tr_item(a.in[IN_FW2], D, kb * 64, nb * 32, (bf16_t*)(ws + WS_W2), DFF, nb * 32, scr, lane); return; }
    it -= IT_F2;
    const int e = it / IT_ME; int r = it % IT_ME;
    if (r < 2 * IT_M1) { const int w3 = r / IT_M1; r %= IT_M1; const int kb = r / 112, nb = r % 112, n0 = nb * 32;
        tr_item((w3 ? a.in[IN_MW3] : a.in[IN_MW1]) + (size_t)e * D * DFE, DFE, kb * 64, n0, (bf16_t*)(ws + WS_MW13) + (size_t)e * 2 * DFE * D, D, (n0 / 128) * 256 + (n0 % 128) + w3 * 128, scr, lane); return; }
    r -= 2 * IT_M1;
    { const int kb = r / 32, nb = r % 32;
      tr_item(a.in[IN_MW2] + (size_t)e * DFE * D, D, kb * 64, nb * 32, (bf16_t*)(ws + WS_MW2) + (size_t)e * D * DFE, DFE, nb * 32, scr, lane); }
}
__device__ __forceinline__ void ph_convert(const KArgs& a, unsigned char* ws, LAS unsigned char* lds, int it_lo, int it_hi, int gw, int ngw, int wave, int lane) {
    LAS float* scr = (LAS float*)(lds + wave * 16384);
    for (int it = it_lo + gw; it < it_hi; it += ngw) conv_item(a, ws, it, scr, lane);
}
__device__ __forceinline__ void ph_mod(const KArgs& a, unsigned char* ws, LAS unsigned char* lds, int blk, int nblk, int tid, int wave, int lane) {
    __syncthreads();
    LAS float* sil = (LAS float*)lds;
    LAS float* red = sil + 3 * D;
    for (int i = tid; i < 3 * D; i += NTHR) { const int s = i / D, k = i % D; sil[i] = silu_f(s < 2 ? a.in[IN_C][s * D + k] : a.in[IN_CCTX][k]); }
    __syncthreads();
    float* mod = (float*)(ws + WS_MOD);
    for (int item = blk; item < 2 * (MODW / 64); item += nblk) {
        const int l = item / (MODW / 64), j0 = (item % (MODW / 64)) * 64;
        const float* w = a.in[IN_WMOD] + ((size_t)l * D + wave * 128) * MODW + j0 + lane;
        float a0 = 0.f, a1 = 0.f, a2 = 0.f;
#pragma unroll 8
        for (int kk = 0; kk < 128; ++kk) { const float wv = w[(size_t)kk * MODW]; const int k = wave * 128 + kk; a0 += sil[k] * wv; a1 += sil[D + k] * wv; a2 += sil[2 * D + k] * wv; }
        red[(wave * 3 + 0) * 64 + lane] = a0; red[(wave * 3 + 1) * 64 + lane] = a1; red[(wave * 3 + 2) * 64 + lane] = a2;
        __syncthreads();
        if (tid < 192) { const int s = tid / 64, j = tid % 64; float v = a.in[IN_BMOD][l * MODW + j0 + j];
#pragma unroll
            for (int w8 = 0; w8 < 8; ++w8) v += red[(w8 * 3 + s) * 64 + j];
            mod[(l * 3 + s) * MODW + j0 + j] = v; }
        __syncthreads();
    }
}
__device__ __forceinline__ void ph_norm(const float* __restrict__ xlat, const float* __restrict__ xctx, const float* __restrict__ g, const float* __restrict__ modl, int cshift, int cscale,
                                        bf16_t* __restrict__ H, int r1, int gw, int ngw, int lane) {
    for (int row = gw; row < r1; row += ngw) {
        const float* src = row < MLAT ? xlat + (size_t)row * D : xctx + (size_t)(row - MLAT) * D;
        const float* md = modl + row_modset(row) * MODW;
        f32x4v v[4]; float ss = 0.f;
#pragma unroll
        for (int j = 0; j < 4; ++j) { v[j] = *(const f32x4v*)(src + (lane + 64 * j) * 4); ss += (v[j].x * v[j].x + v[j].y * v[j].y) + (v[j].z * v[j].z + v[j].w * v[j].w); }
        const float rstd = rsqrtf(wave_sum(ss) * (1.f / D) + EPS);
#pragma unroll
        for (int j = 0; j < 4; ++j) {
            const int col = (lane + 64 * j) * 4;
            const f32x4v gg = *(const f32x4v*)(g + col), sc = *(const f32x4v*)(md + cscale * D + col), sh = *(const f32x4v*)(md + cshift * D + col);
            const f32x4v hv = v[j] * rstd * gg * (1.f + sc) + sh;
            uint2 o; o.x = pk2(hv.x, hv.y); o.y = pk2(hv.z, hv.w);
            *(uint2*)(H + (size_t)row * D + col) = o;
        }
    }
}
__device__ __forceinline__ void ph_route(const KArgs& a, unsigned char* ws, LAS unsigned char* lds, const float* __restrict__ xl, const float* __restrict__ g, const float* __restrict__ modl, int blk, int tid, int wave, int lane) {
    LAS int* se = (LAS int*)lds;
    LAS float* sg = (LAS float*)(lds + 1024);
    bf16_t* H = (bf16_t*)(ws + WS_H);
    const float* rw = a.in[IN_RW]; const float* rb = a.in[IN_RB];
    for (int i = 0; i < 16; ++i) {
        const int tl = wave * 16 + i, row = blk * 128 + tl;
        const float* src = xl + (size_t)row * D; const float* md = modl + row_modset(row) * MODW;
        f32x4v v[4]; float ss = 0.f;
#pragma unroll
        for (int j = 0; j < 4; ++j) { v[j] = *(const f32x4v*)(src + (lane + 64 * j) * 4); ss += (v[j].x * v[j].x + v[j].y * v[j].y) + (v[j].z * v[j].z + v[j].w * v[j].w); }
        const float rstd = rsqrtf(wave_sum(ss) * (1.f / D) + EPS);
        float lg[NEXP] = {0.f, 0.f, 0.f, 0.f, 0.f, 0.f, 0.f, 0.f};
#pragma unroll
        for (int j = 0; j < 4; ++j) {
            const int col = (lane + 64 * j) * 4;
            const f32x4v gg = *(const f32x4v*)(g + col), sc = *(const f32x4v*)(md + 4 * D + col), sh = *(const f32x4v*)(md + 3 * D + col);
            const f32x4v hv = v[j] * rstd * gg * (1.f + sc) + sh;
            uint2 o; o.x = pk2(hv.x, hv.y); o.y = pk2(hv.z, hv.w);
            *(uint2*)(H + (size_t)row * D + col) = o;
#pragma unroll
            for (int q = 0; q < 4; ++q) {
                const f32x4v w0 = *(const f32x4v*)(rw + (size_t)(col + q) * NEXP), w1 = *(const f32x4v*)(rw + (size_t)(col + q) * NEXP + 4);
                const float hq = hv[q];
                lg[0] += hq * w0.x; lg[1] += hq * w0.y; lg[2] += hq * w0.z; lg[3] += hq * w0.w; lg[4] += hq * w1.x; lg[5] += hq * w1.y; lg[6] += hq * w1.z; lg[7] += hq * w1.w;
            }
        }
#pragma unroll
        for (int e = 0; e < NEXP; ++e) lg[e] = wave_sum(lg[e]) + rb[e];
        int e0 = 0; float v0 = lg[0];
#pragma unroll
        for (int e = 1; e < NEXP; ++e) if (lg[e] > v0) { v0 = lg[e]; e0 = e; }
        int e1 = -1; float v1 = -3.4e38f;
#pragma unroll
        for (int e = 0; e < NEXP; ++e) if (e != e0 && lg[e] > v1) { v1 = lg[e]; e1 = e; }
        const float p1 = __expf(v1 - v0), inv = 1.f / (1.f + p1);
        if (lane == 0) { se[tl] = e0; se[128 + tl] = e1; sg[tl] = inv; sg[128 + tl] = p1 * inv; }
    }
    __syncthreads();
    int* sel_e = (int*)(ws + WS_SEL + SEL_E); float* sel_g = (float*)(ws + WS_SEL + SEL_G); int* sel_r = (int*)(ws + WS_SEL + SEL_R);
    int* slot_tok = (int*)(ws + WS_SLOT + SLOT_TOK); int* hist = (int*)(ws + WS_SLOT + SLOT_HIST);
    if (tid < 256) { const int k = tid >> 7, tl = tid & 127, e = se[k * 128 + tl]; int r = 0;
        for (int t2 = 0; t2 < tl; ++t2) r += (se[k * 128 + t2] == e) ? 1 : 0;
        const int t = blk * 128 + tl; sel_e[t * 2 + k] = e; sel_g[t * 2 + k] = sg[k * 128 + tl]; sel_r[t * 2 + k] = r; }
    else if (tid < 256 + 16) { const int j = tid - 256, k = j >> 3, e = j & 7; int c = 0;
        for (int t2 = 0; t2 < 128; ++t2) c += (se[k * 128 + t2] == e) ? 1 : 0;
        hist[blk * 16 + j] = c; }
    for (int i = blk * NTHR + tid; i < 2 * PASS_ROWS; i += NBLK * NTHR) slot_tok[i] = -1;
    __syncthreads();
}
__device__ __forceinline__ void ph_plan(unsigned char* ws, LAS unsigned char* lds, int blk, int tid) {
    LAS int* tot = (LAS int*)lds; LAS int* pre = tot + 16; LAS int* eb = tot + 32;
    const int* hist = (const int*)(ws + WS_SLOT + SLOT_HIST);
    if (tid < 16) { int t = 0, p = 0; for (int bb = 0; bb < NBLK; ++bb) { const int v = hist[bb * 16 + tid]; t += v; p += (bb < blk) ? v : 0; } tot[tid] = t; pre[tid] = p; }
    __syncthreads();
    if (tid == 0) { int* ebg = (int*)(ws + WS_SLOT + SLOT_EBASE);
        for (int k = 0; k < 2; ++k) { int base = 0; for (int e = 0; e <= NEXP; ++e) { eb[k * 9 + e] = base; if (blk == 0) ebg[k * 9 + e] = base; if (e < NEXP) base += (tot[k * 8 + e] + 255) / 256 * 256; } } }
    __syncthreads();
    const int* sel_e = (const int*)(ws + WS_SEL + SEL_E); const float* sel_g = (const float*)(ws + WS_SEL + SEL_G); const int* sel_r = (const int*)(ws + WS_SEL + SEL_R);
    int* slot_tok = (int*)(ws + WS_SLOT + SLOT_TOK); float* slot_gate = (float*)(ws + WS_SLOT + SLOT_GATE);
    if (tid < 256) { const int k = tid >> 7, t = blk * 128 + (tid & 127), e = sel_e[t * 2 + k];
        const int slot = k * PASS_ROWS + eb[k * 9 + e] + pre[k * 8 + e] + sel_r[t * 2 + k]; slot_tok[slot] = t; slot_gate[slot] = sel_g[t * 2 + k]; }
    __syncthreads();
}
__device__ __forceinline__ void ph_final(float* __restrict__ xl, const float* __restrict__ fg, int gw, int ngw, int lane) {
    for (int row = gw; row < MLAT; row += ngw) {
        float* p = xl + (size_t)row * D; f32x4v v[4]; float ss = 0.f;
#pragma unroll
        for (int j = 0; j < 4; ++j) { v[j] = *(const f32x4v*)(p + (lane + 64 * j) * 4); ss += (v[j].x * v[j].x + v[j].y * v[j].y) + (v[j].z * v[j].z + v[j].w * v[j].w); }
        const float rstd = rsqrtf(wave_sum(ss) * (1.f / D) + EPS);
#pragma unroll
        for (int j = 0; j < 4; ++j) { const int col = (lane + 64 * j) * 4; *(f32x4v*)(p + col) = v[j] * rstd * *(const f32x4v*)(fg + col); }
    }
}

__global__ void __launch_bounds__(NTHR, 2) mk_fwd(KArgs a) {
    extern __shared__ __attribute__((aligned(16))) unsigned char lds_raw[];
    LAS unsigned char* lds = (LAS unsigned char*)lds_raw;
    volatile LAS unsigned* MISC = (volatile LAS unsigned*)(lds + MISC_OFF);
    const LAS unsigned* gtab = (const LAS unsigned*)(lds + GTAB_OFF);
    const int tid0 = threadIdx.x;
    const int G = gridDim.x, blk = blockIdx.x;
    const int vcu = (G % 8 == 0) ? (blk % 8) * (G / 8) + blk / 8 : blk;
    const int ngw = G * NWAVES;
    for (int u = tid0; u < 128; u += NTHR) MISC[u] = 0u;
    __syncthreads();
    unsigned char* ws0 = a.ws;
#define PH_ENTER() int tid = tid0; unsigned char* ws = ws0; asm volatile("" : "+v"(tid), "+s"(ws)); const int lane = tid & 63, wave = __builtin_amdgcn_readfirstlane(tid >> 6), gw = vcu * NWAVES + wave; \
    float* mod = (float*)(ws + WS_MOD); float* xc = (float*)(ws + WS_XC); float* xl = a.out; bf16_t* H = (bf16_t*)(ws + WS_H); bf16_t* P = (bf16_t*)(ws + WS_P); bf16_t* Gb = (bf16_t*)(ws + WS_G); bf16_t* YMIX = (bf16_t*)(ws + WS_YMIX); \
    const float* modl = mod + l * 3 * MODW; const float* xl_in = l == 0 ? a.in[IN_X] : xl; const float* xc_in = l == 0 ? a.in[IN_CTX] : xc; \
    (void)lane; (void)wave; (void)gw; (void)mod; (void)xc; (void)xl; (void)H; (void)P; (void)Gb; (void)YMIX; (void)modl; (void)xl_in; (void)xc_in
    XcdBarrier bar = xcd_barrier_post((unsigned*)(ws0 + WS_CTL) + CW_BAR + a.li * XCD_BAR_WORDS, MISC + 8);
    const int lo = a.ph_lo, hi = a.ph_hi;
#define IN(k) (lo <= (k) && (k) < hi)
#define SEAM(k) do { if (IN(k) && IN((k) + 1)) xcd_barrier(bar); } while (0)

    if (IN(PH_PRO)) { const int l = 0; PH_ENTER();
        ph_convert(a, ws, lds, 0, (a.flags & 1) ? IT_DENSE : IT_DENSE + IT_MOE, gw, ngw, wave, lane);
        ph_mod(a, ws, lds, blk, G, tid, wave, lane);
    }
    SEAM(PH_PRO);

    for (int l = 0; l < 2; ++l) {
        const int pb = l == 0 ? PH_N1_0 : PH_N1_1;
        const int ph_g2 = l == 0 ? PH_G2_0 : PH_G2_1;
        if (IN(pb)) { PH_ENTER(); ph_norm(xl_in, xc_in, a.in[IN_N1G] + l * D, modl, 0, 1, H, MT, gw, ngw, lane); }
        SEAM(pb);
        if (IN(pb + 1)) { PH_ENTER();
            pg8::Gemm g{H, (const bf16_t*)(ws + WS_WIN) + (size_t)l * INC * D, 0, MT, INC, D}; pg8::StaticOrder S; S.init(MT, INC, G, blk);
            pg8::EpiStoreBf16 E{P, INC};
            pg8::gemm_phase<pg8::EpiStoreBf16, pg8::StaticOrder, false>(lds, gtab, g, S, E, tid);
        }
        SEAM(pb + 1);
        if (IN(pb + 2)) {   }
        SEAM(pb + 2);
        if (l == 1) {
            if (IN(PH_MOECONV) && (a.flags & 1)) { PH_ENTER(); ph_convert(a, ws, lds, IT_DENSE, IT_DENSE + IT_MOE, gw, ngw, wave, lane); }
            SEAM(PH_MOECONV);
        }
        if (IN(ph_g2)) { PH_ENTER();
            const int rows = l == 0 ? MT : MLAT;
            pg8::Gemm g{YMIX, (const bf16_t*)(ws + WS_WOUT) + (size_t)l * D * D, 0, rows, D, D}; pg8::StaticOrder S; S.init(rows, D, G, blk);
            pg8::EpiResid E{xl_in, xc_in, xl, xc, modl + 2 * D};
            pg8::gemm_phase<pg8::EpiResid, pg8::StaticOrder, false>(lds, gtab, g, S, E, tid);
        }
        SEAM(ph_g2);
        if (l == 0) {
            if (IN(PH_N2_0)) { PH_ENTER(); ph_norm(xl, xc, a.in[IN_N2G] + l * D, modl, 3, 4, H, MT, gw, ngw, lane); }
            SEAM(PH_N2_0);
            if (IN(PH_F1_0)) { PH_ENTER();
                pg8::Gemm g{H, (const bf16_t*)(ws + WS_W13), 0, MT, 2 * DFF, D}; pg8::StaticOrder S; S.init(MT, 2 * DFF, G, blk);
                pg8::EpiSwiglu E{Gb, DFF};
                pg8::gemm_phase<pg8::EpiSwiglu, pg8::StaticOrder, false>(lds, gtab, g, S, E, tid);
            }
            SEAM(PH_F1_0);
            if (IN(PH_F2_0)) { PH_ENTER();
                pg8::Gemm g{Gb, (const bf16_t*)(ws + WS_W2), 0, MT, D, DFF}; pg8::StaticOrder S; S.init(MT, D, G, blk);
                pg8::EpiResid E{xl, xc, xl, xc, modl + 5 * D};
                pg8::gemm_phase<pg8::EpiResid, pg8::StaticOrder, false>(lds, gtab, g, S, E, tid);
            }
            SEAM(PH_F2_0);
        } else {
            if (IN(PH_RT)) { PH_ENTER(); ph_route(a, ws, lds, xl, a.in[IN_N2G] + l * D, modl, blk, tid, wave, lane); }
            SEAM(PH_RT);
            if (IN(PH_PLAN)) { PH_ENTER(); ph_plan(ws, lds, blk, tid); }
            SEAM(PH_PLAN);
            for (int pass = 0; pass < 2; ++pass) {
                const int ph1 = pass == 0 ? PH_M1A : PH_M1B;
                if (IN(ph1)) { PH_ENTER(); const int* ebase = (const int*)(ws + WS_SLOT + SLOT_EBASE); const int* slot_tok = (const int*)(ws + WS_SLOT + SLOT_TOK);
                    pg8::GroupedOrder S; S.init(ebase + pass * 9, 2 * DFE, G, blk);
                    { pg8::Unit u; LAS unsigned* gt = (LAS unsigned*)(lds + GTAB_OFF);
                      for (int i = 0; i < 16 && S.next(i, u); ++i) if (tid < 256) { const int tok = slot_tok[pass * PASS_ROWS + u.pm * 256 + tid]; gt[i * 256 + tid] = (unsigned)(tok < 0 ? 0 : tok) * (unsigned)(D * 2); } }
                    __syncthreads();
                    pg8::Gemm g{H, (const bf16_t*)(ws + WS_MW13), (size_t)2 * DFE * D * 2, 0, 2 * DFE, D};
                    pg8::EpiSwiglu E{Gb, DFE};
                    pg8::gemm_phase<pg8::EpiSwiglu, pg8::GroupedOrder, true>(lds, gtab, g, S, E, tid);
                }
                SEAM(ph1);
                if (IN(ph1 + 1)) { PH_ENTER(); const int* ebase = (const int*)(ws + WS_SLOT + SLOT_EBASE); const int* slot_tok = (const int*)(ws + WS_SLOT + SLOT_TOK); const float* slot_gate = (const float*)(ws + WS_SLOT + SLOT_GATE);
                    pg8::GroupedOrder S; S.init(ebase + pass * 9, D, G, blk);
                    pg8::Gemm g{Gb, (const bf16_t*)(ws + WS_MW2), (size_t)D * DFE * 2, 0, D, DFE};
                    pg8::EpiMoeDown E{xl, slot_tok + pass * PASS_ROWS, slot_gate + pass * PASS_ROWS, modl + 5 * D};
                    pg8::gemm_phase<pg8::EpiMoeDown, pg8::GroupedOrder, false>(lds, gtab, g, S, E, tid);
                }
                SEAM(ph1 + 1);
            }
            if (IN(PH_FIN)) { PH_ENTER(); ph_final(xl, a.in[IN_FG], gw, ngw, lane); }
        }
    }
#undef IN
#undef SEAM
}

extern "C" void kernel_launch(void* const* d_in, const int* in_sizes, int n_in, void* d_out, int out_size, void* d_ws, size_t ws_size, hipStream_t stream) {
    static int ready = 0;
    if (ready == 0) {
        ready = -1;
        if (n_in != 30 || out_size != MLAT * D || in_sizes[0] != MLAT * D || ws_size < WS_END) { fprintf(stderr, "kernel_launch: unexpected shapes / workspace (%d inputs, out %d, ws %zu)\n", n_in, out_size, ws_size); return; }
        int dev = 0, cus = 0;
        if (hipGetDevice(&dev) != hipSuccess || hipDeviceGetAttribute(&cus, hipDeviceAttributeMultiprocessorCount, dev) != hipSuccess) return;
        if (cus < NBLK) { fprintf(stderr, "kernel_launch: needs %d CUs, device has %d\n", NBLK, cus); return; }
        if (hipFuncSetAttribute((const void*)mk_fwd, hipFuncAttributeMaxDynamicSharedMemorySize, LDS_BYTES) != hipSuccess) { fprintf(stderr, "kernel_launch: hipFuncSetAttribute failed\n"); return; }
        int per_cu = 0;
        if (hipOccupancyMaxActiveBlocksPerMultiprocessor(&per_cu, (const void*)mk_fwd, NTHR, LDS_BYTES) != hipSuccess || per_cu < 1) { fprintf(stderr, "kernel_launch: occupancy query says %d blocks per CU\n", per_cu); (void)hipGetLastError(); return; }
        ready = 1;
    }
    if (ready < 0) return;
    (void)hipMemsetAsync((char*)d_ws + WS_CTL, 0, CTL_ZERO_BYTES, stream);
    KArgs a{};
    for (int i = 0; i < 30; ++i) a.in[i] = (const float*)d_in[i];
    a.out = (float*)d_out; a.ws = (unsigned char*)d_ws;
#if HYBRID
    unsigned char* ws = (unsigned char*)d_ws;
    bf16_t* P = (bf16_t*)(ws + WS_P); bf16_t* YMIX = (bf16_t*)(ws + WS_YMIX); float* YRAW = (float*)(ws + WS_YRAW); float* TMP = (float*)(ws + WS_TMP);
    a.flags = 1;
    const int cuts[4] = {PH_PRO, PH_MIX_0, PH_MIX_1, PH_COUNT};
    for (int li = 0; li < 3; ++li) {
        a.ph_lo = li == 0 ? cuts[0] : cuts[li] + 1; a.ph_hi = cuts[li + 1]; a.li = li;
        hipLaunchKernelGGL(mk_fwd, dim3(NBLK), dim3(NTHR), LDS_BYTES, stream, a);
        if (li < 2) {
            const int l = li; const int r1 = l == 1 ? MLAT : MT;
            k_mixA<<<r1, 256, 0, stream>>>(P, a.in[IN_CAW] + l * 3 * 256, YRAW, 0, r1);
            k_mixB1<<<r1, 256, 0, stream>>>(P, a.in[IN_CBW] + l * 31 * 256, a.in[IN_CBB] + l * 256, TMP, 0, r1);
            k_ln256<0><<<r1 / 4, 256, 0, stream>>>(TMP, P, a.in[IN_CLG] + l * 256, a.in[IN_CLB] + l * 256, YRAW, 0, r1);
            k_ln256<1><<<r1 / 4, 256, 0, stream>>>(nullptr, P, a.in[IN_SLG] + l * 256, a.in[IN_SLB] + l * 256, TMP, 0, r1);
            k_mixC2<<<r1, 256, 0, stream>>>(P, TMP, a.in[IN_SGW] + (size_t)l * 4 * 128 * 128, a.in[IN_SGB] + l * 4 * 128, YRAW, 0, r1);
            k_attn<<<r1, 256, 0, stream>>>(P, a.in[IN_RPB] + l * 4 * 15 * 31, YRAW, 0, r1);
            k_groupnorm<<<r1, 256, 0, stream>>>(YRAW, a.in[IN_GG] + l * D, YMIX, 0, r1);
        }
    }
#else
    a.flags = 0; a.ph_lo = 0; a.ph_hi = PH_COUNT; a.li = 0;
    hipLaunchKernelGGL(mk_fwd, dim3(NBLK), dim3(NTHR), LDS_BYTES, stream, a);
#endif
}
```

```cpp
#include <hip/hip_runtime.h>
#include <stdint.h>
#include <stdio.h>

#ifndef MIXER_NAIVE_INKERNEL
#define MIXER_NAIVE_INKERNEL 0
#endif
#ifndef MIXER_FAST
#define MIXER_FAST 1
#endif
#ifndef HYBRID
#define HYBRID 0
#endif

constexpr int D = 1024, BATCH = 2, SEQ = 16384, NCTX = 256;
constexpr int MLAT = BATCH * SEQ;
constexpr int MCTX = BATCH * NCTX;
constexpr int MT = MLAT + MCTX;
constexpr int INC = 2560;
constexpr int OFF_A = 0, OFF_B = 768, OFF_C = 1280, OFF_D = 1792, OFF_KV = 2048;
constexpr int DFF = 2816, NEXP = 8, DFE = 3584;
constexpr int GRID_W = 64, GROWS = SEQ / GRID_W;
constexpr float EPS = 1e-6f;
constexpr int MODW = 6 * D;
constexpr int PASS_ROWS = MLAT + NEXP * 256;
constexpr int NBLK = 256;
constexpr int NTHR = 512, NWAVES = 8;

typedef unsigned short bf16_t;
#define LAS __attribute__((address_space(3)))
#define GAS __attribute__((address_space(1)))
__device__ __forceinline__ float bf2f(bf16_t u) { return __uint_as_float(((unsigned)u) << 16); }
__device__ __forceinline__ bf16_t f2bf(float f) { unsigned u = __float_as_uint(f); return (bf16_t)((u + 0x7fffu + ((u >> 16) & 1u)) >> 16); }
__device__ __forceinline__ unsigned pk2(float lo, float hi) { return (unsigned)f2bf(lo) | ((unsigned)f2bf(hi) << 16); }
__device__ __forceinline__ float wave_sum(float v) {
#pragma unroll
    for (int o = 1; o < 64; o <<= 1) v += __shfl_xor(v, o);
    return v;
}
__device__ __forceinline__ float wave_max(float v) {
#pragma unroll
    for (int o = 1; o < 64; o <<= 1) v = fmaxf(v, __shfl_xor(v, o));
    return v;
}
__device__ __forceinline__ float silu_f(float x) { return x / (1.f + __expf(-x)); }
__device__ __forceinline__ float sigmoid_f(float x) { return 1.f / (1.f + __expf(-x)); }
__device__ __forceinline__ float gelu_tanh_f(float x) { const float u = 0.7978845608028654f * (x + 0.044715f * x * x * x); return 0.5f * x * (1.f + tanhf(u)); }
__device__ __forceinline__ int row_modset(int r) { return r < MLAT ? r / SEQ : 2; }
__device__ __forceinline__ void row_seq(int r, int& s0, int& len) {
    if (r < MLAT) { s0 = (r / SEQ) * SEQ; len = SEQ; } else { s0 = MLAT + ((r - MLAT) / NCTX) * NCTX; len = NCTX; }
}

constexpr size_t MiB = 1ull << 20;
constexpr size_t WS_CTL = 0, CTL_ZERO_BYTES = 1 * MiB;
constexpr size_t WS_MOD = 1 * MiB;
constexpr size_t WS_XC = 2 * MiB;
constexpr size_t WS_SEL = 4 * MiB;
constexpr size_t WS_SLOT = 5 * MiB;
constexpr size_t WS_SGUW = 6 * MiB;
constexpr size_t WS_BIAS = 7 * MiB;
constexpr size_t WS_H = 8 * MiB;
constexpr size_t WS_P = 74 * MiB;
constexpr size_t WS_G = 74 * MiB;
constexpr size_t WS_YMIX = 240 * MiB;
constexpr size_t WS_WIN = 312 * MiB;
constexpr size_t WS_WOUT = 322 * MiB;
constexpr size_t WS_W13 = 326 * MiB;
constexpr size_t WS_W2 = 337 * MiB;
constexpr size_t WS_MW13 = 344 * MiB;
constexpr size_t WS_MW2 = 456 * MiB;
constexpr size_t WS_SLAB0 = 512 * MiB;
constexpr size_t WS_TMP2 = 507 * MiB;
constexpr size_t WS_END = 568 * MiB;
constexpr size_t WS_YRAW = 344 * MiB;
constexpr size_t WS_TMP = 474 * MiB;
static_assert(WS_G + (size_t)PASS_ROWS * DFE * 2 <= WS_WIN && WS_YMIX + (size_t)MT * D * 2 <= WS_WIN && WS_P + (size_t)MT * INC * 2 <= WS_YMIX, "ws map");
static_assert(WS_TMP + (size_t)MT * 256 * 4 <= WS_END, "ws map hybrid");
constexpr size_t SEL_E = 0, SEL_G = (size_t)MLAT * 2 * 4, SEL_R = (size_t)MLAT * 4 * 4, SEL_S = (size_t)MLAT * 6 * 4;
constexpr size_t SLOT_TOK = 0, SLOT_GATE = (size_t)2 * PASS_ROWS * 4, SLOT_HIST = (size_t)4 * PASS_ROWS * 4, SLOT_EBASE = SLOT_HIST + 256 * 16 * 4;
static_assert(SEL_S + (size_t)MLAT * 2 * 4 <= 1 * MiB && SLOT_EBASE + 256 <= 1 * MiB, "route map");
constexpr int CW_BAR = 4096;

constexpr int RING_BYTES = 131072;
constexpr int GTAB_OFF = RING_BYTES, GTAB_BYTES = 16384;
constexpr int MISC_OFF = GTAB_OFF + GTAB_BYTES;
constexpr int LDS_BYTES = MISC_OFF + 512;
#if HYBRID
__global__ void k_mixA(const bf16_t* __restrict__ P, const float* __restrict__ wA  , float* __restrict__ YRAW, int r0, int r1) {
    const int idx = blockIdx.x * 256 + threadIdx.x; const int row = r0 + idx / 256, ch = idx % 256;
    if (row >= r1) return;
    int s0, len; row_seq(row, s0, len); const int t = row - s0;
    float acc = 0.f;
    for (int j = 0; j < 3; ++j) { const int tt = t + j - 1; if (tt < 0 || tt >= len) continue;
        const bf16_t* pr = P + (size_t)(s0 + tt) * INC + OFF_A; acc += wA[j * 256 + ch] * (bf2f(pr[256 + ch]) * bf2f(pr[512 + ch])); }
    YRAW[(size_t)row * D + ch] = bf2f(P[(size_t)row * INC + OFF_A + ch]) * acc;
}
__global__ void k_mixB1(const bf16_t* __restrict__ P, const float* __restrict__ wB  , const float* __restrict__ bB, float* __restrict__ TMP, int r0, int r1) {
    const int idx = blockIdx.x * 256 + threadIdx.x; const int row = r0 + idx / 256, ch = idx % 256;
    if (row >= r1) return;
    int s0, len; row_seq(row, s0, len); const int t = row - s0;
    float acc = bB[ch];
    for (int j = 0; j < 31; ++j) { const int tt = t + j - 15; if (tt < 0 || tt >= len) continue;
        const bf16_t* pr = P + (size_t)(s0 + tt) * INC + OFF_B; acc += wB[j * 256 + ch] * (bf2f(pr[ch]) * sigmoid_f(bf2f(pr[256 + ch]))); }
    TMP[(size_t)row * 256 + ch] = acc;
}
template <int MODE> __global__ void k_ln256(const float* __restrict__ TMPin, const bf16_t* __restrict__ P, const float* __restrict__ g, const float* __restrict__ b, float* __restrict__ dst, int r0, int r1) {
    const int lane = threadIdx.x & 63; const int row = r0 + blockIdx.x * 4 + (threadIdx.x >> 6);
    if (row >= r1) return;
    float v[4];
#pragma unroll
    for (int i = 0; i < 4; ++i) { const int ch = lane * 4 + i; v[i] = MODE == 0 ? TMPin[(size_t)row * 256 + ch] : gelu_tanh_f(bf2f(P[(size_t)row * INC + OFF_C + 256 + ch])); }
    const float mu = wave_sum(v[0] + v[1] + v[2] + v[3]) * (1.f / 256.f);
    float q = 0.f;
#pragma unroll
    for (int i = 0; i < 4; ++i) { v[i] -= mu; q += v[i] * v[i]; }
    const float rstd = rsqrtf(wave_sum(q) * (1.f / 256.f) + EPS);
#pragma unroll
    for (int i = 0; i < 4; ++i) { const int ch = lane * 4 + i; const float y = v[i] * rstd * g[ch] + b[ch];
        if (MODE == 0) dst[(size_t)row * D + 256 + ch] = silu_f(y); else dst[(size_t)row * 256 + ch] = y; }
}
__global__ void k_mixC2(const bf16_t* __restrict__ P, const float* __restrict__ VN  , const float* __restrict__ ws  , const float* __restrict__ bs  , float* __restrict__ YRAW, int r0, int r1) {
    const int idx = blockIdx.x * 256 + threadIdx.x; const int row = r0 + idx / 256, ch = idx % 256;
    if (row >= r1) return;
    int s0, len; row_seq(row, s0, len); const int t = row - s0; const int cb = s0 + (t / 128) * 128, pl = t % 128, h = ch / 64;
    float acc = bs[h * 128 + pl];
    const float* wr = ws + ((size_t)h * 128 + pl) * 128;
    for (int q = 0; q < 128; ++q) acc += wr[q] * VN[(size_t)(cb + q) * 256 + ch];
    YRAW[(size_t)row * D + 512 + ch] = gelu_tanh_f(bf2f(P[(size_t)row * INC + OFF_C + ch])) * acc;
}
__global__ __launch_bounds__(256) void k_attn(const bf16_t* __restrict__ P, const float* __restrict__ rpb  , float* __restrict__ YRAW, int r0, int r1) {
    __shared__ float sc[4][384];
    const int lane = threadIdx.x & 63, w = threadIdx.x >> 6;
    const int item = blockIdx.x * 4 + w; const int row = r0 + item / 4, h = item % 4;
    if (row >= r1) return;
    const bool lat = row < MLAT;
    const int b = lat ? row / SEQ : (row - MLAT) / NCTX;
    const int t = lat ? row % SEQ : 0, gr = t / GRID_W, gc = t % GRID_W;
    const int kr0 = min(max(gr - 4, 0), GROWS - 8), c0 = min(max(gc - 8, 0), GRID_W - 16);
    const int nloc = lat ? 128 : 0, nk = nloc + NCTX;
    const float q = bf2f(P[(size_t)row * INC + OFF_D + h * 64 + lane]) * 0.125f;
    float* s = sc[w];
    for (int i = 0; i < nk; ++i) {
        int krow; float bias = 0.f;
        if (i < nloc) { const int kr = kr0 + i / 16, kc = c0 + i % 16; krow = b * SEQ + kr * GRID_W + kc; bias = rpb[(h * 15 + (kr - gr + 7)) * 31 + (kc - gc + 15)]; }
        else krow = MLAT + b * NCTX + (i - nloc);
        const float d = wave_sum(q * bf2f(P[(size_t)krow * INC + OFF_KV + h * 64 + lane])) + bias;
        if (lane == 0) s[i] = d;
    }
    __syncthreads();
    float m = -1e30f;
    for (int i = lane; i < nk; i += 64) m = fmaxf(m, s[i]);
    m = wave_max(m);
    float sum = 0.f;
    for (int i = lane; i < nk; i += 64) { const float e = __expf(s[i] - m); s[i] = e; sum += e; }
    sum = wave_sum(sum);
    __syncthreads();
    float o = 0.f;
    for (int i = 0; i < nk; ++i) {
        int krow;
        if (i < nloc) { const int kr = kr0 + i / 16, kc = c0 + i % 16; krow = b * SEQ + kr * GRID_W + kc; }
        else krow = MLAT + b * NCTX + (i - nloc);
        o += s[i] * bf2f(P[(size_t)krow * INC + OFF_KV + 256 + h * 64 + lane]);
    }
    YRAW[(size_t)row * D + 768 + h * 64 + lane] = o / sum;
}
__global__ void k_groupnorm(const float* __restrict__ YRAW, const float* __restrict__ gg  , bf16_t* __restrict__ YMIX, int r0, int r1) {
    const int lane = threadIdx.x & 63; const int item = blockIdx.x * 4 + (threadIdx.x >> 6); const int row = r0 + item / 4, g = item % 4;
    if (row >= r1) return;
    const float4 v = *(const float4*)(YRAW + (size_t)row * D + g * 256 + lane * 4);
    const float rstd = rsqrtf(wave_sum(v.x * v.x + v.y * v.y + v.z * v.z + v.w * v.w) * (1.f / 256.f) + EPS);
    const float4 w = *(const float4*)(gg + g * 256 + lane * 4);
    ushort4 o; o.x = f2bf(v.x * rstd * w.x); o.y = f2bf(v.y * rstd * w.y); o.z = f2bf(v.z * rstd * w.z); o.w = f2bf(v.w * rstd * w.w);
    *(ushort4*)(YMIX + (size_t)row * D + g * 256 + lane * 4) = o;
}

#endif

namespace pg8 {
typedef short bf16x8 __attribute__((ext_vector_type(8)));
typedef float f32x4 __attribute__((ext_vector_type(4)));
typedef unsigned u32x4 __attribute__((ext_vector_type(4)));
constexpr int BM = 256, BK = 64, HALF = 128, HTB = HALF * BK * 2  , STAGE_BYTES = 8 * HTB, NXCD = 8, WGM = 8;

__host__ __device__ __forceinline__ int lds_byte(int r, int c) { const int st = (r >> 4) * 2 + (c >> 5), rr = r & 15, cc = c & 31, ob = rr * 64 + cc * 2; return st * 1024 + (ob ^ (((ob >> 9) & 1) << 5)); }
__host__ __device__ __forceinline__ void stage_rc(int b, int& R, int& C) { const int st = b / 1024, sb = b % 1024, swz = sb ^ (((sb >> 9) & 1) << 5); R = (st >> 1) * 16 + swz / 64; C = (st & 1) * 32 + (swz % 64) / 2; }
__host__ __device__ __forceinline__ int perm32(int rho) { const int n = rho >> 4, i = rho & 15; return 8 * (i >> 2) + 4 * n + (i & 3); }

struct Unit { int pm, pn, e, kt0, nkt, slab; };
struct Gemm { const bf16_t* A; const bf16_t* Bt; size_t bstride; int M, N, K; };

struct StaticOrder {
    int nM, nN, nwg, G, c;
    __host__ __device__ void init(int M, int N, int G_, int c_) { nM = M / BM; nN = N / BM; nwg = nM * nN; G = G_; c = c_; }
    __host__ __device__ bool next(int i, Unit& u) const {
        const long L = (long)i * G + c; if (L >= nwg) return false;
        int wgid = (int)L; { const int q = nwg / NXCD, r = nwg % NXCD, xcd = wgid % NXCD, off = wgid / NXCD; wgid = (xcd < r ? xcd * (q + 1) : r * (q + 1) + (xcd - r) * q) + off; }
        const int nig = WGM * nN, gid = wgid / nig, fm = gid * WGM, gsz = (nM - fm) < WGM ? (nM - fm) : WGM;
        u.pm = fm + ((wgid % nig) % gsz); u.pn = (wgid % nig) / gsz; u.e = 0; u.kt0 = 0; u.nkt = 0; u.slab = -1; return true;
    }
};
struct DenseTailOrder {
    StaticOrder so; int nreg_c, ntail, G, c, pm0, S, nkt;
    __device__ void init(int Mreg, int N, int G_, int c_, int ntt, int S_, int nkt_) { so.init(Mreg, N, G_, c_); G = G_; c = c_; pm0 = Mreg / BM; S = S_; nkt = nkt_;
        ntail = ntt * so.nN * S; nreg_c = so.nwg > c ? (so.nwg - c + G - 1) / G : 0; }
    __device__ bool next(int i, Unit& u) const {
        if (i < nreg_c) return so.next(i, u);
        const long q = (long)(i - nreg_c) * G + c; if (q >= ntail) return false;
        u.pm = pm0 + (int)(q / (so.nN * S)); u.pn = (int)((q / S) % so.nN); u.e = 0; u.kt0 = (int)(q % S) * nkt; u.nkt = nkt; u.slab = (int)q; return true;
    }
};
struct OneUnit {
    int pm, pn;
    __device__ bool next(int i, Unit& u) const { if (i != 0) return false; u.pm = pm; u.pn = pn; u.e = 0; u.kt0 = 0; u.nkt = 0; u.slab = -1; return true; }
};
struct GroupedOrder {
    StaticOrder so; int et[9];
    __device__ void init(const int* ebase_rows, int N, int G_, int c_) {
#pragma unroll
        for (int i = 0; i < 9; ++i) et[i] = __builtin_amdgcn_readfirstlane(ebase_rows[i]) / BM;
        so.init(et[8] * BM, N, G_, c_);
    }
    __device__ bool next(int i, Unit& u) const {
        if (!so.next(i, u)) return false;
        int e = 0;
#pragma unroll
        for (int k = 1; k < 8; ++k) e += (u.pm >= et[k]) ? 1 : 0;
        u.e = e; return true;
    }
};

constexpr int SPLITK = 7, SPLIT_NKT = 8;
struct GroupedTailOrder {
    StaticOrder so; int et[9]; int treg, ntail, nreg_c, G, c;
    __device__ void init(const int* ebase_rows, int N, int G_, int c_) {
#pragma unroll
        for (int i = 0; i < 9; ++i) et[i] = __builtin_amdgcn_readfirstlane(ebase_rows[i]) / BM;
        const int nN = N / BM, T = et[8]; G = G_; c = c_;
        const int R = (T * nN) / G; treg = (R * G) / nN; if (treg > T) treg = T; if (T - treg > 8) treg = T;
        ntail = (T - treg) * nN * SPLITK; so.init(treg * BM, N, G_, c_);
        nreg_c = so.nwg > c ? (so.nwg - c + G - 1) / G : 0;
    }
    __device__ bool next(int i, Unit& u) const {
        if (i < nreg_c) { so.next(i, u); }
        else { const long q = (long)(i - nreg_c) * G + c; if (q >= ntail) return false;
            const int nN = so.nN; u.pm = treg + (int)(q / (nN * SPLITK)); u.pn = (int)((q / SPLITK) % nN); u.kt0 = (int)(q % SPLITK) * SPLIT_NKT; u.nkt = SPLIT_NKT; u.slab = (int)q; }
        int e = 0;
#pragma unroll
        for (int k = 1; k < 8; ++k) e += (u.pm >= et[k]) ? 1 : 0;
        u.e = e; return true;
    }
};

typedef float f32x2c __attribute__((ext_vector_type(2))); typedef __bf16 bf16x2c __attribute__((ext_vector_type(2)));
__device__ __forceinline__ unsigned cvt_pk_bf16(float lo, float hi) { const f32x2c v = {lo, hi}; const bf16x2c b = __builtin_convertvector(v, bf16x2c); return __builtin_bit_cast(unsigned, b); }

struct EpiStoreBf16 {
    static constexpr bool PERM = true;
    bf16_t* O; int ldc;
    __device__ __forceinline__ void operator()(const f32x4 (&acc)[2][2][4][2], const Unit& u, int wr, int wc, int fr, int fq) const {
        const int row0 = u.pm * BM + wr * 64 + fr, col0 = u.pn * BM + wc * 32 + 8 * fq;
#pragma unroll
        for (int ai = 0; ai < 2; ++ai)
#pragma unroll
            for (int m = 0; m < 4; ++m) { bf16_t* rowp = O + (size_t)(row0 + ai * HALF + m * 16) * ldc + col0;
#pragma unroll
                for (int bj = 0; bj < 2; ++bj) { const f32x4 v0 = acc[ai][bj][m][0], v1 = acc[ai][bj][m][1];
                    u32x4 w; w.x = cvt_pk_bf16(v0[0], v0[1]); w.y = cvt_pk_bf16(v0[2], v0[3]); w.z = cvt_pk_bf16(v1[0], v1[1]); w.w = cvt_pk_bf16(v1[2], v1[3]);
                    *(u32x4*)(rowp + bj * HALF) = w; } }
    }
};
__device__ __forceinline__ float silu_fast(float x) { return x * __builtin_amdgcn_rcpf(1.f + __builtin_amdgcn_exp2f(-1.4426950408889634f * x)); }
struct EpiSwiglu {
    static constexpr bool PERM = true;
    bf16_t* G; int ldg;
    __device__ __forceinline__ void operator()(const f32x4 (&acc)[2][2][4][2], const Unit& u, int wr, int wc, int fr, int fq) const {
        const int row0 = u.pm * BM + wr * 64 + fr, col0 = u.pn * HALF + wc * 32 + 8 * fq;
#pragma unroll
        for (int ai = 0; ai < 2; ++ai)
#pragma unroll
            for (int m = 0; m < 4; ++m) {
                const f32x4 a0 = acc[ai][0][m][0], a1 = acc[ai][0][m][1], b0 = acc[ai][1][m][0], b1 = acc[ai][1][m][1];
                u32x4 w;
                w.x = cvt_pk_bf16(silu_fast(a0[0]) * b0[0], silu_fast(a0[1]) * b0[1]); w.y = cvt_pk_bf16(silu_fast(a0[2]) * b0[2], silu_fast(a0[3]) * b0[3]);
                w.z = cvt_pk_bf16(silu_fast(a1[0]) * b1[0], silu_fast(a1[1]) * b1[1]); w.w = cvt_pk_bf16(silu_fast(a1[2]) * b1[2], silu_fast(a1[3]) * b1[3]);
                *(u32x4*)(G + (size_t)(row0 + ai * HALF + m * 16) * ldg + col0) = w; }
    }
};
struct EpiResid {
    static constexpr bool PERM = false;
    const float* base_lat; const float* base_ctx; float* out_lat; float* out_ctx; const float* gate; float* slabs;
    __device__ __forceinline__ void operator()(const f32x4 (&acc)[2][2][4][2], const Unit& u, int wr, int wc, int fr, int fq) const {
        if (u.slab >= 0) {
            float* sp = slabs + (size_t)u.slab * (BM * BM) + (size_t)(wr * 64 + fr) * BM + wc * 32 + 4 * fq;
#pragma unroll
            for (int ai = 0; ai < 2; ++ai)
#pragma unroll
                for (int m = 0; m < 4; ++m)
#pragma unroll
                    for (int bj = 0; bj < 2; ++bj)
#pragma unroll
                        for (int n = 0; n < 2; ++n) *(f32x4*)(sp + (size_t)(ai * HALF + m * 16) * BM + bj * HALF + n * 16) = acc[ai][bj][m][n];
            return;
        }
        const bool lat = u.pm < MLAT / BM;
        const int set = lat ? (u.pm >= SEQ / BM ? 1 : 0) : 2 + 0 * u.pm;
        const float* gt = gate + (lat ? set : 2) * MODW;
        const float* bs = lat ? base_lat : base_ctx; float* op = lat ? out_lat : out_ctx;
        const int row0 = (lat ? u.pm * BM : (u.pm - MLAT / BM) * BM) + wr * 64 + fr, col0 = u.pn * BM + wc * 32 + 4 * fq;
        f32x4 gv[2][2];
#pragma unroll
        for (int bj = 0; bj < 2; ++bj)
#pragma unroll
            for (int n = 0; n < 2; ++n) gv[bj][n] = *(const f32x4*)(gt + col0 + bj * HALF + n * 16);
#pragma unroll
        for (int ai = 0; ai < 2; ++ai)
#pragma unroll
            for (int m = 0; m < 4; ++m) { const size_t off = (size_t)(row0 + ai * HALF + m * 16) * D + col0;
#pragma unroll
                for (int bj = 0; bj < 2; ++bj)
#pragma unroll
                    for (int n = 0; n < 2; ++n) { const f32x4 b = *(const f32x4*)(bs + off + bj * HALF + n * 16);
                        *(f32x4*)(op + off + bj * HALF + n * 16) = b + gv[bj][n] * acc[ai][bj][m][n]; } }
    }
};
struct EpiMoeDown {
    static constexpr bool PERM = false;
    float* xl; const int* slot_tok; const float* slot_gate; const float* g2; float* slabs;
    __device__ __forceinline__ void operator()(const f32x4 (&acc)[2][2][4][2], const Unit& u, int wr, int wc, int fr, int fq) const {
        if (u.slab >= 0) {
            float* sp = slabs + (size_t)u.slab * (BM * BM) + (size_t)(wr * 64 + fr) * BM + wc * 32 + 4 * fq;
#pragma unroll
            for (int ai = 0; ai < 2; ++ai)
#pragma unroll
                for (int m = 0; m < 4; ++m)
#pragma unroll
                    for (int bj = 0; bj < 2; ++bj)
#pragma unroll
                        for (int n = 0; n < 2; ++n) *(f32x4*)(sp + (size_t)(ai * HALF + m * 16) * BM + bj * HALF + n * 16) = acc[ai][bj][m][n];
            return;
        }
        const int row0 = u.pm * BM + wr * 64 + fr, col0 = u.pn * BM + wc * 32 + 4 * fq;
#pragma unroll
        for (int ai = 0; ai < 2; ++ai)
#pragma unroll
            for (int m = 0; m < 4; ++m) { const int slot = row0 + ai * HALF + m * 16; const int tok = slot_tok[slot];
                if (tok < 0) continue;
                const float sg = slot_gate[slot]; const float* gt = g2 + (tok >= SEQ ? MODW : 0) + col0; float* xp = xl + (size_t)tok * D + col0;
#pragma unroll
                for (int bj = 0; bj < 2; ++bj)
#pragma unroll
                    for (int n = 0; n < 2; ++n) { const f32x4 gq = *(const f32x4*)(gt + bj * HALF + n * 16); const f32x4 b = *(const f32x4*)(xp + bj * HALF + n * 16);
                        *(f32x4*)(xp + bj * HALF + n * 16) = b + (gq * sg) * acc[ai][bj][m][n]; } }
    }
};

template <class Epi, class Sched, bool GATHER, bool ALIGN_EPI = true>
__device__ __forceinline__ void gemm_phase(LAS unsigned char* lds, const LAS unsigned* gtab, const Gemm g, const Sched& S, const Epi& E, const int tid) {
    const int wid = __builtin_amdgcn_readfirstlane(tid >> 6), lane = tid & 63, wr = wid >> 2, wc = wid & 3, fr = lane & 15, fq = lane >> 4;
    const int K = g.K, ntfull = K / BK;
    const size_t kstep = (size_t)(BK * 2);
    const size_t hstep = (size_t)HALF * K * 2;
    const size_t tstep = 2 * hstep;
    unsigned voffB[2], ga[2][2], gan[2][2]; int RA[2]; unsigned CA2[2];
#pragma unroll
    for (int i = 0; i < 2; ++i) { int R, C; stage_rc(tid * 16 + i * 8192, R, C); const int Rb = Epi::PERM ? ((R & ~31) + perm32(R & 31)) : R;
        voffB[i] = (unsigned)(Rb * K + C) * 2u; RA[i] = R; CA2[i] = (unsigned)C * 2u;
        if (!GATHER) { ga[0][i] = (unsigned)(R * K + C) * 2u; ga[1][i] = ga[0][i] + (unsigned)hstep; gan[0][i] = ga[0][i]; gan[1][i] = ga[1][i]; } }
    const unsigned ldsw = (unsigned)wid * 1024u;
    const int aoff = lds_byte(wr * 64 + fr, fq * 8), boff = lds_byte(wc * 32 + fr, fq * 8);
#define PG8_SA(b, h) (((b) * 2 + (h)) * HTB)
#define PG8_SB(b, h) ((4 + (b) * 2 + (h)) * HTB)
#define PG8_STAGE(bufoff, gbase, voff) do { _Pragma("unroll") for (int _i = 0; _i < 2; ++_i) \
        __builtin_amdgcn_global_load_lds((const unsigned*)((const char*)(gbase) + (voff)[_i]), (LAS unsigned*)(lds + (bufoff) + ldsw + _i * 8192), 16, 0, 0); } while (0)
#define PG8_LDA(dst, b, h) do { _Pragma("unroll") for (int m = 0; m < 4; ++m) _Pragma("unroll") for (int k = 0; k < 2; ++k) dst[m][k] = *(const LAS bf16x8*)(lds + PG8_SA(b, h) + aoff + m * 2048 + k * 1024); } while (0)
#define PG8_LDB(dst, b, h) do { _Pragma("unroll") for (int n = 0; n < 2; ++n) _Pragma("unroll") for (int k = 0; k < 2; ++k) dst[n][k] = *(const LAS bf16x8*)(lds + PG8_SB(b, h) + boff + n * 2048 + k * 1024); } while (0)
#define PG8_MMA(ai, bj, At, Bt) do { __builtin_amdgcn_s_setprio(1); _Pragma("unroll") for (int m = 0; m < 4; ++m) _Pragma("unroll") for (int n = 0; n < 2; ++n) _Pragma("unroll") for (int k = 0; k < 2; ++k) \
        acc[ai][bj][m][n] = __builtin_amdgcn_mfma_f32_16x16x32_bf16(Bt[n][k], At[m][k], acc[ai][bj][m][n], 0, 0, 0); __builtin_amdgcn_s_setprio(0); } while (0)
#define PG8_WAIT_V(n) asm volatile("s_waitcnt vmcnt(" #n ")" ::: "memory")
#define PG8_WAIT_L(n) asm volatile("s_waitcnt lgkmcnt(" #n ")" ::: "memory")
#define PG8_BAR __builtin_amdgcn_s_barrier()
#define PG8_SCHED __builtin_amdgcn_sched_barrier(0)
#define PG8_GLOAD(dst, ui_) do { _Pragma("unroll") for (int _h = 0; _h < 2; ++_h) _Pragma("unroll") for (int _i = 0; _i < 2; ++_i) dst[_h][_i] = gtab[(ui_) * 256 + _h * HALF + RA[_i]] + CA2[_i]; } while (0)
    Unit cur, nxt; int ui = 0;
    if (!S.next(0, cur)) return;
    f32x4 acc[2][2][4][2];
#pragma unroll
    for (int a = 0; a < 2; ++a)
#pragma unroll
        for (int b = 0; b < 2; ++b)
#pragma unroll
            for (int m = 0; m < 4; ++m)
#pragma unroll
                for (int n = 0; n < 2; ++n) acc[a][b][m][n] = (f32x4){0.f, 0.f, 0.f, 0.f};
    bf16x8 At[4][2], B0[2][2], B1[2][2];
    const char* cA = (const char*)g.A + (GATHER ? (size_t)0 : (size_t)cur.pm * tstep) + (size_t)cur.kt0 * kstep;
    const char* cB = (const char*)g.Bt + (size_t)cur.e * g.bstride + (size_t)cur.pn * tstep + (size_t)cur.kt0 * kstep;
    if (GATHER) PG8_GLOAD(ga, 0);
    PG8_STAGE(PG8_SB(0, 0), cB, voffB); PG8_STAGE(PG8_SB(0, 1), cB + hstep, voffB); PG8_STAGE(PG8_SA(0, 0), cA, ga[0]); PG8_STAGE(PG8_SA(0, 1), cA, ga[1]);
    if (wr == 1) PG8_BAR;
    PG8_WAIT_V(2); PG8_BAR;
    PG8_STAGE(PG8_SB(1, 0), cB + kstep, voffB); PG8_STAGE(PG8_SA(1, 0), cA + kstep, ga[0]); PG8_STAGE(PG8_SB(1, 1), cB + hstep + kstep, voffB);
    PG8_WAIT_V(6); PG8_BAR;
    for (;;) {
        const bool has_next = S.next(ui + 1, nxt);
        const char* nA = has_next ? (const char*)g.A + (GATHER ? (size_t)0 : (size_t)nxt.pm * tstep) + (size_t)nxt.kt0 * kstep : cA;
        const char* nB = has_next ? (const char*)g.Bt + (size_t)nxt.e * g.bstride + (size_t)nxt.pn * tstep + (size_t)nxt.kt0 * kstep : cB;
        const int nt = cur.nkt ? cur.nkt : ntfull;
        if (GATHER) { if (has_next) PG8_GLOAD(gan, ui + 1); else { _Pragma("unroll") for (int h = 0; h < 2; ++h) _Pragma("unroll") for (int i = 0; i < 2; ++i) gan[h][i] = ga[h][i]; } }
        for (int t = 0; t < nt; t += 2) {
            const bool last = (t == nt - 2);
            const char* a1 = cA + (size_t)(t + 1) * kstep;
            const char* a2 = last ? nA : cA + (size_t)(t + 2) * kstep; const char* b2 = last ? nB : cB + (size_t)(t + 2) * kstep;
            const char* a3 = a2 + kstep; const char* b3 = b2 + kstep;
            unsigned s2[2][2];
#pragma unroll
            for (int h = 0; h < 2; ++h)
#pragma unroll
                for (int i = 0; i < 2; ++i) s2[h][i] = (GATHER && last) ? gan[h][i] : ga[h][i];
            PG8_LDB(B0, 0, 0); PG8_LDB(B1, 0, 1); PG8_SCHED; PG8_LDA(At, 0, 0); PG8_STAGE(PG8_SA(1, 1), a1, ga[1]);
            PG8_WAIT_V(8); PG8_WAIT_L(0); PG8_BAR; PG8_MMA(0, 0, At, B0); PG8_MMA(0, 1, At, B1); PG8_BAR; PG8_SCHED;
            PG8_LDA(At, 0, 1); PG8_STAGE(PG8_SB(0, 0), b2, voffB); PG8_STAGE(PG8_SB(0, 1), b2 + hstep, voffB); PG8_STAGE(PG8_SA(0, 0), a2, s2[0]);
            PG8_WAIT_V(8); PG8_WAIT_L(0); PG8_BAR; PG8_MMA(1, 0, At, B0); PG8_MMA(1, 1, At, B1); PG8_BAR; PG8_SCHED;
            PG8_LDB(B0, 1, 0); PG8_LDB(B1, 1, 1); PG8_SCHED; PG8_LDA(At, 1, 0); PG8_STAGE(PG8_SA(0, 1), a2, s2[1]);
            PG8_WAIT_V(8); PG8_WAIT_L(0); PG8_BAR; PG8_MMA(0, 0, At, B0); PG8_MMA(0, 1, At, B1); PG8_BAR; PG8_SCHED;
            PG8_LDA(At, 1, 1); PG8_STAGE(PG8_SB(1, 0), b3, voffB); PG8_STAGE(PG8_SB(1, 1), b3 + hstep, voffB); PG8_STAGE(PG8_SA(1, 0), a3, s2[0]);
            PG8_WAIT_V(8); PG8_WAIT_L(0); PG8_BAR; PG8_MMA(1, 0, At, B0); PG8_MMA(1, 1, At, B1); PG8_BAR; PG8_SCHED;
        }
        if (ALIGN_EPI && wr == 0) PG8_BAR;
        E(acc, cur, wr, wc, fr, fq);
        if (!has_next) break;
#pragma unroll
        for (int a = 0; a < 2; ++a)
#pragma unroll
            for (int b = 0; b < 2; ++b)
#pragma unroll
                for (int m = 0; m < 4; ++m)
#pragma unroll
                    for (int n = 0; n < 2; ++n) acc[a][b][m][n] = (f32x4){0.f, 0.f, 0.f, 0.f};
        cur = nxt; cA = nA; cB = nB; ++ui;
#pragma unroll
        for (int h = 0; h < 2; ++h)
#pragma unroll
            for (int i = 0; i < 2; ++i) ga[h][i] = gan[h][i];
        if (ALIGN_EPI && wr == 1) PG8_BAR;
    }
    PG8_WAIT_V(0);
    if (!ALIGN_EPI && wr == 0) PG8_BAR;
    PG8_BAR;
#undef PG8_SA
#undef PG8_SB
#undef PG8_STAGE
#undef PG8_LDA
#undef PG8_LDB
#undef PG8_MMA
#undef PG8_WAIT_V
#undef PG8_WAIT_L
#undef PG8_BAR
#undef PG8_SCHED
#undef PG8_GLOAD
}
}

#define XB_TMO      128
#define XB_XCNT(j)  (256  + 64 * (j))
#define XB_XSUB(j)  (1280 + 64 * (j))
#define XB_XGEN(j)  (2304 + 64 * (j))
#define XB_TOP      3328
#define XB_TOPGEN   3392
#define XCD_BAR_WORDS 3456
#define XB_SPIN_CAP (1u << 18)

__device__ __forceinline__ unsigned xb_ld(unsigned* p)              { return __hip_atomic_load(p, __ATOMIC_RELAXED, __HIP_MEMORY_SCOPE_AGENT); }
__device__ __forceinline__ unsigned xb_add(unsigned* p, unsigned v) { return __hip_atomic_fetch_add(p, v, __ATOMIC_RELAXED, __HIP_MEMORY_SCOPE_AGENT); }
__device__ __forceinline__ unsigned xb_xcc_id() { return (unsigned)__builtin_amdgcn_s_getreg((3 << 11) | 20) & 0xFu; }
#define XB_SPIN(cond, bar) do { unsigned _sp = 0; while (cond) { __builtin_amdgcn_s_sleep(1); \
    if ((++_sp & 255u) == 0u) { if (xb_ld(&(bar)[XB_TMO])) break; if (_sp > XB_SPIN_CAP) { atomicAdd(&(bar)[XB_TMO], 1u); break; } } } } while (0)

struct XcdBarrier {
    unsigned* bar; unsigned x;
    volatile LAS unsigned* st;
};
__device__ __forceinline__ XcdBarrier xcd_barrier_post(unsigned* bar, volatile LAS unsigned* st) {
    XcdBarrier b; b.bar = bar; b.x = xb_xcc_id(); b.st = st;
    if (threadIdx.x == 0) (void)xb_add(&bar[XB_XCNT(b.x)], 1u);
    return b;
}
__device__ __forceinline__ void xcd_barrier_complete(unsigned* bar, unsigned x, unsigned& nloc, unsigned& nx) {
    const unsigned G = gridDim.x * gridDim.y * gridDim.z;
    unsigned sum, cnt, mine, sp = 0u;
    for (;;) {
        sum = 0u; cnt = 0u; mine = 0u;
#pragma unroll
        for (unsigned j = 0; j < 16; ++j) { const unsigned c = xb_ld(&bar[XB_XCNT(j)]); sum += c; cnt += (c > 0u) ? 1u : 0u; mine = (j == x) ? c : mine; }
        if (sum == G) break;
        __builtin_amdgcn_s_sleep(1);
        if ((++sp & 255u) == 0u) { if (xb_ld(&bar[XB_TMO])) break; if (sp > XB_SPIN_CAP) { atomicAdd(&bar[XB_TMO], 1u); break; } }
    }
    nloc = mine > 0u ? mine : 1u; nx = cnt > 0u ? cnt : 1u;
}
__device__ __forceinline__ void xcd_barrier(const XcdBarrier& b) {
    asm volatile("s_waitcnt vmcnt(0)" ::: "memory");
    __syncthreads();
    if (threadIdx.x == 0) {
        unsigned* bar = b.bar;
        __builtin_amdgcn_s_waitcnt(0);
        unsigned nloc = b.st[0], nx = b.st[1];
        if (nloc == 0u) { xcd_barrier_complete(bar, b.x, nloc, nx); b.st[0] = nloc; b.st[1] = nx; }
        const unsigned old = xb_add(&bar[XB_XSUB(b.x)], 1u);
        const unsigned gen = old / nloc;
        if (old + 1u == (gen + 1u) * nloc) {
            __builtin_amdgcn_fence(__ATOMIC_RELEASE, "agent");
            asm volatile("s_waitcnt vmcnt(0)" ::: "memory");
            const unsigned og = xb_add(&bar[XB_TOP], 1u);
            const unsigned tg = og / nx;
            if (og + 1u == (tg + 1u) * nx) xb_add(&bar[XB_TOPGEN], 1u);
            else XB_SPIN(xb_ld(&bar[XB_TOPGEN]) == tg, bar);
            __builtin_amdgcn_fence(__ATOMIC_ACQUIRE, "agent");
            xb_add(&bar[XB_XGEN(b.x)], 1u);
            asm volatile("s_waitcnt vmcnt(0)" ::: "memory");
        } else {
            XB_SPIN(xb_ld(&bar[XB_XGEN(b.x)]) == gen, bar);
            __builtin_amdgcn_fence(__ATOMIC_ACQUIRE, "agent");
            asm volatile("s_waitcnt vmcnt(0)" ::: "memory");
        }
    }
    __syncthreads();
}

typedef float f32x4v __attribute__((ext_vector_type(4)));
typedef unsigned u32x4v __attribute__((ext_vector_type(4)));

__device__ __forceinline__ void tr_item(const float* __restrict__ W, int ldn, int k0, int n0, bf16_t* __restrict__ WT, int ldk, int drow0, LAS float* scr, int lane) {
    float wv[32];
#pragma unroll
    for (int i = 0; i < 32; ++i) { const int kk = 2 * i + (lane >> 5); wv[i] = __builtin_nontemporal_load(W + (size_t)(k0 + kk) * ldn + n0 + (lane & 31)); }
#pragma unroll
    for (int i = 0; i < 32; ++i) { const int kk = 2 * i + (lane >> 5); scr[kk * 33 + (lane & 31)] = wv[i]; }
    asm volatile("s_waitcnt lgkmcnt(0)" ::: "memory");
    const int c = lane & 7;
#pragma unroll
    for (int j = 0; j < 4; ++j) { const int n = (lane >> 3) + 8 * j; const LAS float* s = scr + (8 * c) * 33 + n;
        u32x4v o; o.x = pk2(s[0 * 33], s[1 * 33]); o.y = pk2(s[2 * 33], s[3 * 33]); o.z = pk2(s[4 * 33], s[5 * 33]); o.w = pk2(s[6 * 33], s[7 * 33]);
        __builtin_nontemporal_store(o, (u32x4v*)(WT + (size_t)(drow0 + n) * ldk + k0 + 8 * c)); }
    asm volatile("s_waitcnt lgkmcnt(0)" ::: "memory");
}
struct KArgs {
    const float* in[30]; float* out; unsigned char* ws;
    int ph_lo, ph_hi, li, flags;
};
enum { IN_X = 0, IN_C, IN_CTX, IN_CCTX, IN_WMOD, IN_BMOD, IN_N1G, IN_N2G, IN_WIN, IN_CAW, IN_CBW, IN_CBB, IN_CLG, IN_CLB, IN_SLG, IN_SLB, IN_SGW, IN_SGB, IN_RPB, IN_GG, IN_WOUT,
       IN_FW1, IN_FW3, IN_FW2, IN_RW, IN_RB, IN_MW1, IN_MW3, IN_MW2, IN_FG };
enum { PH_PRO = 0, PH_N1_0, PH_G1_0, PH_MIX_0, PH_G2_0, PH_N2_0, PH_F1_0, PH_F2_0, PH_N1_1, PH_G1_1, PH_MIX_1, PH_MOECONV, PH_G2_1, PH_RT, PH_PLAN, PH_M1A, PH_M2A, PH_M1B, PH_M2B, PH_FIN, PH_COUNT };

constexpr int IT_WIN = 2 * 16 * 80, IT_WOUT = 2 * 16 * 32, IT_F1 = 16 * 88, IT_F2 = 44 * 32, IT_DENSE = IT_WIN + IT_WOUT + 2 * IT_F1 + IT_F2;
constexpr int IT_M1 = 16 * 112, IT_M2 = 56 * 32, IT_ME = 2 * IT_M1 + IT_M2, IT_MOE = NEXP * IT_ME;
__device__ __forceinline__ void conv_item(const KArgs& a, unsigned char* ws, int it, LAS float* scr, int lane) {
    if (it < IT_WIN) { const int l = it / 1280, r = it % 1280, kb = r / 80, nb = r % 80;
        tr_item(a.in[IN_WIN] + (size_t)l * D * INC, INC, kb * 64, nb * 32, (bf16_t*)(ws + WS_WIN) + (size_t)l * INC * D, D, nb * 32, scr, lane); return; }
    it -= IT_WIN;
    if (it < IT_WOUT) { const int l = it / 512, r = it % 512, kb = r / 32, nb = r % 32;
        tr_item(a.in[IN_WOUT] + (size_t)l * D * D, D, kb * 64, nb * 32, (bf16_t*)(ws + WS_WOUT) + (size_t)l * D * D, D, nb * 32, scr, lane); return; }
    it -= IT_WOUT;
    if (it < 2 * IT_F1) { const int w3 = it / IT_F1, r = it % IT_F1, kb = r / 88, nb = r % 88, n0 = nb * 32;
        tr_item((w3 ? a.in[IN_FW3] : a.in[IN_FW1]), DFF, kb * 64, n0, (bf16_t*)(ws + WS_W13), D, (n0 / 128) * 256 + (n0 % 128) + w3 * 128, scr, lane); return; }
    it -= 2 * IT_F1;
    if (it < IT_F2) { const int kb = it / 32, nb = it % 32;
        tr_item(a.in[IN_FW2], D, kb * 64, nb * 32, (bf16_t*)(ws + WS_W2), DFF, nb * 32, scr, lane); return; }
    it -= IT_F2;
    const int e = it / IT_ME; int r = it % IT_ME;
    if (r < 2 * IT_M1) { const int w3 = r / IT_M1; r %= IT_M1; const int kb = r / 112, nb = r % 112, n0 = nb * 32;
        tr_item((w3 ? a.in[IN_MW3] : a.in[IN_MW1]) + (size_t)e * D * DFE, DFE, kb * 64, n0, (bf16_t*)(ws + WS_MW13) + (size_t)e * 2 * DFE * D, D, (n0 / 128) * 256 + (n0 % 128) + w3 * 128, scr, lane); return; }
    r -= 2 * IT_M1;
    { const int kb = r / 32, nb = r % 32;
      tr_item(a.in[IN_MW2] + (size_t)e * DFE * D, D, kb * 64, nb * 32, (bf16_t*)(ws + WS_MW2) + (size_t)e * D * DFE, DFE, nb * 32, scr, lane); }
}
__device__ __forceinline__ void ph_convert(const KArgs& a, unsigned char* ws, LAS unsigned char* lds, int it_lo, int it_hi, int gw, int ngw, int wave, int lane) {
    LAS float* scr = (LAS float*)(lds + wave * 16384);
    for (int it = it_lo + gw; it < it_hi; it += ngw) conv_item(a, ws, it, scr, lane);
}
__device__ __forceinline__ void ph_mod(const KArgs& a, unsigned char* ws, LAS unsigned char* lds, int blk, int nblk, int tid, int wave, int lane) {
    __syncthreads();
    LAS float* sil = (LAS float*)lds;
    LAS float* red = sil + 3 * D;
    for (int i = tid; i < 3 * D; i += NTHR) { const int s = i / D, k = i % D; sil[i] = silu_f(s < 2 ? a.in[IN_C][s * D + k] : a.in[IN_CCTX][k]); }
    __syncthreads();
    float* mod = (float*)(ws + WS_MOD);
    for (int item = blk; item < 2 * (MODW / 64); item += nblk) {
        const int l = item / (MODW / 64), j0 = (item % (MODW / 64)) * 64;
        const float* w = a.in[IN_WMOD] + ((size_t)l * D + wave * 128) * MODW + j0 + lane;
        float a0 = 0.f, a1 = 0.f, a2 = 0.f;
#pragma unroll 8
        for (int kk = 0; kk < 128; ++kk) { const float wv = w[(size_t)kk * MODW]; const int k = wave * 128 + kk; a0 += sil[k] * wv; a1 += sil[D + k] * wv; a2 += sil[2 * D + k] * wv; }
        red[(wave * 3 + 0) * 64 + lane] = a0; red[(wave * 3 + 1) * 64 + lane] = a1; red[(wave * 3 + 2) * 64 + lane] = a2;
        __syncthreads();
        if (tid < 192) { const int s = tid / 64, j = tid % 64; float v = a.in[IN_BMOD][l * MODW + j0 + j];
#pragma unroll
            for (int w8 = 0; w8 < 8; ++w8) v += red[(w8 * 3 + s) * 64 + j];
            mod[(l * 3 + s) * MODW + j0 + j] = v; }
        __syncthreads();
    }
}
#define DPP_ADD(v, ctrl) (v) += __builtin_bit_cast(float, __builtin_amdgcn_mov_dpp(__builtin_bit_cast(int, (v)), (ctrl), 0xf, 0xf, true))
__device__ __forceinline__ float wave_sum_fast(float v) {
    DPP_ADD(v, 0xB1); DPP_ADD(v, 0x4E); DPP_ADD(v, 0x141); DPP_ADD(v, 0x140);
    const int iv = __builtin_bit_cast(int, v);
    const float r0 = __builtin_bit_cast(float, __builtin_amdgcn_readlane(iv, 0)), r1 = __builtin_bit_cast(float, __builtin_amdgcn_readlane(iv, 16));
    const float r2 = __builtin_bit_cast(float, __builtin_amdgcn_readlane(iv, 32)), r3 = __builtin_bit_cast(float, __builtin_amdgcn_readlane(iv, 48));
    return (r0 + r1) + (r2 + r3);
}
constexpr int F2_SPLITK = 11, F2_NKT = 4;
__device__ __forceinline__ void ph_norm(const float* __restrict__ xlat, const float* __restrict__ xctx, const float* __restrict__ g, const float* __restrict__ modl, int cshift, int cscale,
                                        bf16_t* __restrict__ H, int r1, int gw, int ngw, int lane, const float* __restrict__ slabs = nullptr, const float* __restrict__ sgate = nullptr) {
    f32x4v nx[4];
    if (gw < r1) { const float* src = gw < MLAT ? xlat + (size_t)gw * D : xctx + (size_t)(gw - MLAT) * D;
#pragma unroll
        for (int j = 0; j < 4; ++j) nx[j] = *(const f32x4v*)(src + (lane + 64 * j) * 4); }
    for (int row = gw; row < r1; row += ngw) {
        const float* md = modl + row_modset(row) * MODW;
        f32x4v v[4]; float ss = 0.f;
#pragma unroll
        for (int j = 0; j < 4; ++j) { v[j] = nx[j]; ss += (v[j].x * v[j].x + v[j].y * v[j].y) + (v[j].z * v[j].z + v[j].w * v[j].w); }
        const int rn = row + ngw;
        if (rn < r1) { const float* src = rn < MLAT ? xlat + (size_t)rn * D : xctx + (size_t)(rn - MLAT) * D;
#pragma unroll
            for (int j = 0; j < 4; ++j) nx[j] = *(const f32x4v*)(src + (lane + 64 * j) * 4); }
        if (slabs && row >= MLAT) {
            const int tile = (row - MLAT) >> 8, r = (row - MLAT) & 255; ss = 0.f;
#pragma unroll
            for (int j = 0; j < 4; ++j) { const int col = (lane + 64 * j) * 4; f32x4v s4 = (f32x4v){0.f, 0.f, 0.f, 0.f};
                for (int s = 0; s < F2_SPLITK; ++s) s4 += *(const f32x4v*)(slabs + ((size_t)((tile * 4 + j) * F2_SPLITK + s) * 256 + r) * 256 + (col & 255));
                v[j] += s4 * *(const f32x4v*)(sgate + col); ss += (v[j].x * v[j].x + v[j].y * v[j].y) + (v[j].z * v[j].z + v[j].w * v[j].w); } }
        const float rstd = rsqrtf(wave_sum_fast(ss) * (1.f / D) + EPS);
#pragma unroll
        for (int j = 0; j < 4; ++j) {
            const int col = (lane + 64 * j) * 4;
            const f32x4v gg = *(const f32x4v*)(g + col), sc = *(const f32x4v*)(md + cscale * D + col), sh = *(const f32x4v*)(md + cshift * D + col);
            const f32x4v hv = v[j] * rstd * gg * (1.f + sc) + sh;
            uint2 o; o.x = pk2(hv.x, hv.y); o.y = pk2(hv.z, hv.w);
            *(uint2*)(H + (size_t)row * D + col) = o;
        }
    }
}
__device__ __forceinline__ void ph_route(const KArgs& a, unsigned char* ws, LAS unsigned char* lds, const float* __restrict__ xl, const float* __restrict__ g, const float* __restrict__ modl, int blk, int tid, int wave, int lane) {
    LAS int* se = (LAS int*)lds;
    LAS float* sg = (LAS float*)(lds + 1024);
    bf16_t* H = (bf16_t*)(ws + WS_H);
    const float* rw = a.in[IN_RW]; const float* rb = a.in[IN_RB];
    const float* md = modl + row_modset(blk * 128) * MODW;
    f32x4v wA[4], wB[4]; float wr[16][8];
#pragma unroll
    for (int j = 0; j < 4; ++j) { const int col = (lane + 64 * j) * 4;
        wA[j] = *(const f32x4v*)(g + col) * (1.f + *(const f32x4v*)(md + 4 * D + col)); wB[j] = *(const f32x4v*)(md + 3 * D + col);
#pragma unroll
        for (int q = 0; q < 4; ++q) { const f32x4v w0 = *(const f32x4v*)(rw + (size_t)(col + q) * NEXP), w1 = *(const f32x4v*)(rw + (size_t)(col + q) * NEXP + 4);
            wr[j * 4 + q][0] = w0.x; wr[j * 4 + q][1] = w0.y; wr[j * 4 + q][2] = w0.z; wr[j * 4 + q][3] = w0.w; wr[j * 4 + q][4] = w1.x; wr[j * 4 + q][5] = w1.y; wr[j * 4 + q][6] = w1.z; wr[j * 4 + q][7] = w1.w; } }
    float rbv[NEXP];
#pragma unroll
    for (int e = 0; e < NEXP; ++e) rbv[e] = rb[e];
    const int row0 = blk * 128 + wave * 16;
    f32x4v nx[4], ny[4];
#pragma unroll
    for (int j = 0; j < 4; ++j) { nx[j] = *(const f32x4v*)(xl + (size_t)row0 * D + (lane + 64 * j) * 4); ny[j] = *(const f32x4v*)(xl + (size_t)(row0 + 1) * D + (lane + 64 * j) * 4); }
    for (int i = 0; i < 16; ++i) {
        const int tl = wave * 16 + i, row = row0 + i;
        f32x4v v[4]; float ss = 0.f;
#pragma unroll
        for (int j = 0; j < 4; ++j) { v[j] = nx[j]; nx[j] = ny[j]; ss += (v[j].x * v[j].x + v[j].y * v[j].y) + (v[j].z * v[j].z + v[j].w * v[j].w); }
        if (i + 2 < 16) {
#pragma unroll
            for (int j = 0; j < 4; ++j) ny[j] = *(const f32x4v*)(xl + (size_t)(row + 2) * D + (lane + 64 * j) * 4);
        }
        const float rstd = rsqrtf(wave_sum_fast(ss) * (1.f / D) + EPS);
        float lg[NEXP] = {0.f, 0.f, 0.f, 0.f, 0.f, 0.f, 0.f, 0.f};
#pragma unroll
        for (int j = 0; j < 4; ++j) {
            const int col = (lane + 64 * j) * 4;
            const f32x4v hv = v[j] * rstd * wA[j] + wB[j];
            uint2 o; o.x = pk2(hv.x, hv.y); o.y = pk2(hv.z, hv.w);
            *(uint2*)(H + (size_t)row * D + col) = o;
#pragma unroll
            for (int q = 0; q < 4; ++q) {
                const float hq = hv[q];
#pragma unroll
                for (int e = 0; e < NEXP; ++e) lg[e] += hq * wr[j * 4 + q][e];
            }
        }
#pragma unroll
        for (int e = 0; e < NEXP; ++e) lg[e] = wave_sum_fast(lg[e]) + rbv[e];
        int e0 = 0; float v0 = lg[0];
#pragma unroll
        for (int e = 1; e < NEXP; ++e) if (lg[e] > v0) { v0 = lg[e]; e0 = e; }
        int e1 = -1; float v1 = -3.4e38f;
#pragma unroll
        for (int e = 0; e < NEXP; ++e) if (e != e0 && lg[e] > v1) { v1 = lg[e]; e1 = e; }
        const float p1 = __expf(v1 - v0), inv = 1.f / (1.f + p1);
        if (lane == 0) { se[tl] = e0; se[128 + tl] = e1; sg[tl] = inv; sg[128 + tl] = p1 * inv; }
    }
#pragma unroll
    for (int j = 0; j < 4; ++j) asm volatile("" :: "v"(nx[j]), "v"(ny[j]));
    __syncthreads();
    int* sel_e = (int*)(ws + WS_SEL + SEL_E); float* sel_g = (float*)(ws + WS_SEL + SEL_G); int* sel_r = (int*)(ws + WS_SEL + SEL_R);
    int* slot_tok = (int*)(ws + WS_SLOT + SLOT_TOK); int* hist = (int*)(ws + WS_SLOT + SLOT_HIST);
    if (tid < 256) { const int k = tid >> 7, tl = tid & 127, e = se[k * 128 + tl]; int r = 0;
        for (int t2 = 0; t2 < tl; ++t2) r += (se[k * 128 + t2] == e) ? 1 : 0;
        const int t = blk * 128 + tl; sel_e[t * 2 + k] = e; sel_g[t * 2 + k] = sg[k * 128 + tl]; sel_r[t * 2 + k] = r; }
    else if (tid < 256 + 16) { const int j = tid - 256, k = j >> 3, e = j & 7; int c = 0;
        for (int t2 = 0; t2 < 128; ++t2) c += (se[k * 128 + t2] == e) ? 1 : 0;
        hist[blk * 16 + j] = c; }
    for (int i = blk * NTHR + tid; i < 2 * PASS_ROWS; i += NBLK * NTHR) slot_tok[i] = -1;
    __syncthreads();
}
__device__ __forceinline__ void ph_plan(unsigned char* ws, LAS unsigned char* lds, int blk, int tid) {
    LAS int* tot = (LAS int*)lds; LAS int* pre = tot + 16; LAS int* eb = tot + 32;
    const int* hist = (const int*)(ws + WS_SLOT + SLOT_HIST);
    LAS int* hl = (LAS int*)(lds + GTAB_OFF);
    for (int i = tid; i < NBLK * 16; i += NTHR) hl[i] = hist[i];
    __syncthreads();
    if (tid < 16) { int t = 0, p = 0; for (int bb = 0; bb < NBLK; ++bb) { const int v = hl[bb * 16 + tid]; t += v; p += (bb < blk) ? v : 0; } tot[tid] = t; pre[tid] = p; }
    __syncthreads();
    if (tid == 0) { int* ebg = (int*)(ws + WS_SLOT + SLOT_EBASE);
        for (int k = 0; k < 2; ++k) { int base = 0; for (int e = 0; e <= NEXP; ++e) { eb[k * 9 + e] = base; if (blk == 0) ebg[k * 9 + e] = base; if (e < NEXP) base += (tot[k * 8 + e] + 255) / 256 * 256; } } }
    __syncthreads();
    const int* sel_e = (const int*)(ws + WS_SEL + SEL_E); const float* sel_g = (const float*)(ws + WS_SEL + SEL_G); const int* sel_r = (const int*)(ws + WS_SEL + SEL_R);
    int* slot_tok = (int*)(ws + WS_SLOT + SLOT_TOK); float* slot_gate = (float*)(ws + WS_SLOT + SLOT_GATE);
    if (tid < 256) { const int k = tid >> 7, t = blk * 128 + (tid & 127), e = sel_e[t * 2 + k];
        const int ps = eb[k * 9 + e] + pre[k * 8 + e] + sel_r[t * 2 + k], slot = k * PASS_ROWS + ps; slot_tok[slot] = t; slot_gate[slot] = sel_g[t * 2 + k]; ((int*)(ws + WS_SEL + SEL_S))[t * 2 + k] = ps; }
    __syncthreads();
}
__device__ __forceinline__ void ph_final(float* __restrict__ xl, const float* __restrict__ fg, unsigned char* ws, const float* __restrict__ g2l  , int gw, int ngw, int lane) {
    const int* ebase = (const int*)(ws + WS_SLOT + SLOT_EBASE); const int* sel_s = (const int*)(ws + WS_SEL + SEL_S); const float* sel_g = (const float*)(ws + WS_SEL + SEL_G);
    int tail0[2];
#pragma unroll
    for (int k = 0; k < 2; ++k) { const int T = ebase[k * 9 + 8] / 256, R = (T * 4) / NBLK; int treg = (R * NBLK) / 4; if (treg > T) treg = T; if (T - treg > 8) treg = T; tail0[k] = treg * 256; }
    f32x4v nx[4];
    if (gw < MLAT) {
#pragma unroll
        for (int j = 0; j < 4; ++j) nx[j] = *(const f32x4v*)(xl + (size_t)gw * D + (lane + 64 * j) * 4); }
    for (int row = gw; row < MLAT; row += ngw) {
        float* p = xl + (size_t)row * D; f32x4v v[4];
#pragma unroll
        for (int j = 0; j < 4; ++j) v[j] = nx[j];
        if (row + ngw < MLAT) {
#pragma unroll
            for (int j = 0; j < 4; ++j) nx[j] = *(const f32x4v*)(xl + (size_t)(row + ngw) * D + (lane + 64 * j) * 4); }
#pragma unroll
        for (int k = 0; k < 2; ++k) { const int ps = sel_s[row * 2 + k];
            if (ps >= tail0[k]) {
                const int tt = (ps - tail0[k]) >> 8, r = (ps - tail0[k]) & 255; const float sg = sel_g[row * 2 + k];
                const float* slabs = (const float*)(ws + (k == 0 ? WS_SLAB0 : WS_H)); const float* gt = g2l + (row >= SEQ ? MODW : 0);
#pragma unroll
                for (int j = 0; j < 4; ++j) { const int col = (lane + 64 * j) * 4; f32x4v s4 = (f32x4v){0.f, 0.f, 0.f, 0.f};
                    for (int s = 0; s < pg8::SPLITK; ++s) s4 += *(const f32x4v*)(slabs + ((size_t)((tt * 4 + j) * pg8::SPLITK + s) * 256 + r) * 256 + (col & 255));
                    v[j] += s4 * sg * *(const f32x4v*)(gt + col); } } }
        float ss = 0.f;
#pragma unroll
        for (int j = 0; j < 4; ++j) ss += (v[j].x * v[j].x + v[j].y * v[j].y) + (v[j].z * v[j].z + v[j].w * v[j].w);
        const float rstd = rsqrtf(wave_sum_fast(ss) * (1.f / D) + EPS);
#pragma unroll
        for (int j = 0; j < 4; ++j) { const int col = (lane + 64 * j) * 4; *(f32x4v*)(p + col) = v[j] * rstd * *(const f32x4v*)(fg + col); }
    }
}

__device__ __forceinline__ void nv_mixA(const bf16_t* __restrict__ P, const float* __restrict__ wA, float* __restrict__ YRAW, int r1, int vb0, int nvb, int ch) {
    for (int row = vb0; row < r1; row += nvb) {
        int s0, len; row_seq(row, s0, len); const int t = row - s0;
        float acc = 0.f;
        for (int j = 0; j < 3; ++j) { const int tt = t + j - 1; if (tt < 0 || tt >= len) continue;
            const bf16_t* pr = P + (size_t)(s0 + tt) * INC + OFF_A; acc += wA[j * 256 + ch] * (bf2f(pr[256 + ch]) * bf2f(pr[512 + ch])); }
        YRAW[(size_t)row * D + ch] = bf2f(P[(size_t)row * INC + OFF_A + ch]) * acc;
    }
}
__device__ __forceinline__ void nv_mixB1(const bf16_t* __restrict__ P, const float* __restrict__ wB, const float* __restrict__ bB, float* __restrict__ TMP, int r1, int vb0, int nvb, int ch) {
    for (int row = vb0; row < r1; row += nvb) {
        int s0, len; row_seq(row, s0, len); const int t = row - s0;
        float acc = bB[ch];
        for (int j = 0; j < 31; ++j) { const int tt = t + j - 15; if (tt < 0 || tt >= len) continue;
            const bf16_t* pr = P + (size_t)(s0 + tt) * INC + OFF_B; acc += wB[j * 256 + ch] * (bf2f(pr[ch]) * sigmoid_f(bf2f(pr[256 + ch]))); }
        TMP[(size_t)row * 256 + ch] = acc;
    }
}
template <int MODE> __device__ __forceinline__ void nv_ln256(const float* __restrict__ TMPin, const bf16_t* __restrict__ P, const float* __restrict__ g, const float* __restrict__ b, float* __restrict__ dst, int r1, int gw, int ngw, int lane) {
    for (int row = gw; row < r1; row += ngw) {
        float v[4];
#pragma unroll
        for (int i = 0; i < 4; ++i) { const int ch = lane * 4 + i; v[i] = MODE == 0 ? TMPin[(size_t)row * 256 + ch] : gelu_tanh_f(bf2f(P[(size_t)row * INC + OFF_C + 256 + ch])); }
        const float mu = wave_sum(v[0] + v[1] + v[2] + v[3]) * (1.f / 256.f);
        float q = 0.f;
#pragma unroll
        for (int i = 0; i < 4; ++i) { v[i] -= mu; q += v[i] * v[i]; }
        const float rstd = rsqrtf(wave_sum(q) * (1.f / 256.f) + EPS);
#pragma unroll
        for (int i = 0; i < 4; ++i) { const int ch = lane * 4 + i; const float y = v[i] * rstd * g[ch] + b[ch];
            if (MODE == 0) dst[(size_t)row * D + 256 + ch] = silu_f(y); else dst[(size_t)row * 256 + ch] = y; }
    }
}
__device__ __forceinline__ void nv_mixC2(const bf16_t* __restrict__ P, const float* __restrict__ VN, const float* __restrict__ wsg, const float* __restrict__ bs, float* __restrict__ YRAW, int r1, int vb0, int nvb, int ch) {
    for (int row = vb0; row < r1; row += nvb) {
        int s0, len; row_seq(row, s0, len); const int t = row - s0; const int cb = s0 + (t / 128) * 128, pl = t % 128, h = ch / 64;
        float acc = bs[h * 128 + pl];
        const float* wr = wsg + ((size_t)h * 128 + pl) * 128;
        for (int q = 0; q < 128; ++q) acc += wr[q] * VN[(size_t)(cb + q) * 256 + ch];
        YRAW[(size_t)row * D + 512 + ch] = gelu_tanh_f(bf2f(P[(size_t)row * INC + OFF_C + ch])) * acc;
    }
}
__device__ __forceinline__ void nv_attn(const bf16_t* __restrict__ P, const float* __restrict__ rpb, float* __restrict__ YRAW, int r1, int gw, int ngw, int lane, LAS float* s) {
    for (int item = gw; item < r1 * 4; item += ngw) {
        const int row = item >> 2, h = item & 3;
        const bool lat = row < MLAT;
        const int b = lat ? row / SEQ : (row - MLAT) / NCTX;
        const int t = lat ? row % SEQ : 0, gr = t / GRID_W, gc = t % GRID_W;
        const int kr0 = min(max(gr - 4, 0), GROWS - 8), c0 = min(max(gc - 8, 0), GRID_W - 16);
        const int nloc = lat ? 128 : 0, nk = nloc + NCTX;
        const float q = bf2f(P[(size_t)row * INC + OFF_D + h * 64 + lane]) * 0.125f;
        for (int i = 0; i < nk; ++i) {
            int krow; float bias = 0.f;
            if (i < nloc) { const int kr = kr0 + i / 16, kc = c0 + i % 16; krow = b * SEQ + kr * GRID_W + kc; bias = rpb[(h * 15 + (kr - gr + 7)) * 31 + (kc - gc + 15)]; }
            else krow = MLAT + b * NCTX + (i - nloc);
            const float d = wave_sum(q * bf2f(P[(size_t)krow * INC + OFF_KV + h * 64 + lane])) + bias;
            if (lane == 0) s[i] = d;
        }
        asm volatile("s_waitcnt lgkmcnt(0)" ::: "memory");
        float m = -1e30f;
        for (int i = lane; i < nk; i += 64) m = fmaxf(m, s[i]);
        m = wave_max(m);
        float sum = 0.f;
        for (int i = lane; i < nk; i += 64) { const float e = __expf(s[i] - m); s[i] = e; sum += e; }
        sum = wave_sum(sum);
        asm volatile("s_waitcnt lgkmcnt(0)" ::: "memory");
        float o = 0.f;
        for (int i = 0; i < nk; ++i) {
            int krow;
            if (i < nloc) { const int kr = kr0 + i / 16, kc = c0 + i % 16; krow = b * SEQ + kr * GRID_W + kc; }
            else krow = MLAT + b * NCTX + (i - nloc);
            o += s[i] * bf2f(P[(size_t)krow * INC + OFF_KV + 256 + h * 64 + lane]);
        }
        YRAW[(size_t)row * D + 768 + h * 64 + lane] = o / sum;
        asm volatile("s_waitcnt lgkmcnt(0)" ::: "memory");
    }
}
__device__ __forceinline__ void nv_groupnorm(const float* __restrict__ YRAW, const float* __restrict__ gg, bf16_t* __restrict__ YMIX, int r1, int gw, int ngw, int lane) {
    for (int item = gw; item < r1 * 4; item += ngw) {
        const int row = item >> 2, g = item & 3;
        const f32x4v v = *(const f32x4v*)(YRAW + (size_t)row * D + g * 256 + lane * 4);
        const float rstd = rsqrtf(wave_sum((v.x * v.x + v.y * v.y) + (v.z * v.z + v.w * v.w)) * (1.f / 256.f) + EPS);
        const f32x4v w = *(const f32x4v*)(gg + g * 256 + lane * 4);
        uint2 o; o.x = pk2(v.x * rstd * w.x, v.y * rstd * w.y); o.y = pk2(v.z * rstd * w.z, v.w * rstd * w.w);
        *(uint2*)(YMIX + (size_t)row * D + g * 256 + lane * 4) = o;
    }
}

#ifndef MX_A
#define MX_A 1
#endif
#ifndef MX_B
#define MX_B 1
#endif
#ifndef MX_C
#define MX_C 1
#endif
#ifndef MX_D
#define MX_D 1
#endif
namespace mx {
typedef short bf16x8 __attribute__((ext_vector_type(8)));
typedef short s16x4 __attribute__((ext_vector_type(4)));
typedef float f32x4 __attribute__((ext_vector_type(4)));
typedef float f32x16 __attribute__((ext_vector_type(16)));
typedef unsigned u32x4 __attribute__((ext_vector_type(4)));
constexpr float LOG2E = 1.4426950408889634f;
__device__ __forceinline__ float gelu_fast(float x) {
    const float u = 0.7978845608028654f * (x + 0.044715f * x * x * x);
    return x * __builtin_amdgcn_rcpf(1.f + __builtin_amdgcn_exp2f(-2.f * LOG2E * u));
}
__device__ __forceinline__ float sigmoid_fast(float x) { return __builtin_amdgcn_rcpf(1.f + __builtin_amdgcn_exp2f(-LOG2E * x)); }
__device__ __forceinline__ f32x4 ld_bf4(const bf16_t* p) { const uint2 v = *(const uint2*)p; return (f32x4){__uint_as_float(v.x << 16), __uint_as_float(v.x & 0xffff0000u), __uint_as_float(v.y << 16), __uint_as_float(v.y & 0xffff0000u)}; }
__device__ __forceinline__ void st_bf4(bf16_t* p, f32x4 v);
typedef float f32x2_t __attribute__((ext_vector_type(2))); typedef __bf16 bf16x2_t __attribute__((ext_vector_type(2)));
__device__ __forceinline__ unsigned cvtpk(float lo, float hi) { const f32x2_t v = {lo, hi}; const bf16x2_t b = __builtin_convertvector(v, bf16x2_t); return __builtin_bit_cast(unsigned, b); }
__device__ __forceinline__ float sum4(f32x4 v) { return (v.x + v.y) + (v.z + v.w); }
__device__ __forceinline__ void st_bf4(bf16_t* p, f32x4 v) { uint2 o; o.x = cvtpk(v.x, v.y); o.y = cvtpk(v.z, v.w); *(uint2*)p = o; }

__device__ __forceinline__ void item_A(const bf16_t* __restrict__ P, const float* __restrict__ wA  , const float* __restrict__ gg  , bf16_t* __restrict__ YMIX, int r0, int wave, int lane) {
    int s0, len; row_seq(r0, s0, len);
    const int ch = lane * 4, t0 = r0 - s0 + wave * 16;
    const f32x4 w0 = *(const f32x4*)(wA + ch), w1 = *(const f32x4*)(wA + 256 + ch), w2 = *(const f32x4*)(wA + 512 + ch), g = *(const f32x4*)(gg + ch);
    f32x4 u[18];
#pragma unroll
    for (int i = 0; i < 18; ++i) { const int tt = t0 + i - 1;
        if (tt >= 0 && tt < len) { const bf16_t* pr = P + (size_t)(s0 + tt) * INC + OFF_A + ch; u[i] = ld_bf4(pr + 256) * ld_bf4(pr + 512); } else u[i] = (f32x4){0.f, 0.f, 0.f, 0.f}; }
#pragma unroll
    for (int i = 0; i < 16; ++i) { const size_t row = (size_t)(s0 + t0 + i);
        const f32x4 y = ld_bf4(P + row * INC + OFF_A + ch) * (w0 * u[i] + w1 * u[i + 1] + w2 * u[i + 2]);
        const float rstd = rsqrtf(wave_sum_fast(sum4(y * y)) * (1.f / 256.f) + EPS);
        st_bf4(YMIX + row * D + ch, y * rstd * g); }
}

__device__ __forceinline__ void item_B(const bf16_t* __restrict__ P, const float* __restrict__ wB  , const float* __restrict__ bB, const float* __restrict__ lg, const float* __restrict__ lb,
                                       const float* __restrict__ gg  , bf16_t* __restrict__ YMIX, LAS unsigned char* lds, int r0, int wave, int lane) {
    int s0, len; row_seq(r0, s0, len);
    const int ch = lane * 4;
    LAS float* tile = (LAS float*)lds;
    f32x4 w[31];
#pragma unroll
    for (int j = 0; j < 31; ++j) w[j] = *(const f32x4*)(wB + j * 256 + ch);
    const f32x4 bias = *(const f32x4*)(bB + ch), g1 = *(const f32x4*)(lg + ch), b1 = *(const f32x4*)(lb + ch), g2 = *(const f32x4*)(gg + ch);
    for (int sub = 0; sub < 2; ++sub) {
        const int t0 = r0 - s0 + sub * 64;
        { uint2 ra[12], rg[12];
#pragma unroll
          for (int i = 0; i < 12; ++i) { const int rr = wave + 8 * i, tt = t0 - 15 + rr; ra[i] = make_uint2(0u, 0u); rg[i] = make_uint2(0u, 0u);
              if (rr < 94 && tt >= 0 && tt < len) { const bf16_t* pr = P + (size_t)(s0 + tt) * INC + OFF_B + ch; ra[i] = *(const uint2*)pr; rg[i] = *(const uint2*)(pr + 256); } }
#pragma unroll
          for (int i = 0; i < 12; ++i) { const int rr = wave + 8 * i;
              if (rr < 94) { const f32x4 a = (f32x4){__uint_as_float(ra[i].x << 16), __uint_as_float(ra[i].x & 0xffff0000u), __uint_as_float(ra[i].y << 16), __uint_as_float(ra[i].y & 0xffff0000u)};
                  const f32x4 gt = (f32x4){__uint_as_float(rg[i].x << 16), __uint_as_float(rg[i].x & 0xffff0000u), __uint_as_float(rg[i].y << 16), __uint_as_float(rg[i].y & 0xffff0000u)};
                  *(LAS f32x4*)(tile + rr * 256 + ch) = (f32x4){a.x * sigmoid_fast(gt.x), a.y * sigmoid_fast(gt.y), a.z * sigmoid_fast(gt.z), a.w * sigmoid_fast(gt.w)}; } } }
        __syncthreads();
        f32x4 acc[8];
#pragma unroll
        for (int o = 0; o < 8; ++o) acc[o] = bias;
#pragma unroll
        for (int rr = 0; rr < 38; ++rr) { const f32x4 v = *(const LAS f32x4*)(tile + (wave * 8 + rr) * 256 + ch);
#pragma unroll
            for (int o = 0; o < 8; ++o) { const int j = rr - o; if (j >= 0 && j < 31) acc[o] += w[j] * v; } }
#pragma unroll
        for (int o = 0; o < 8; ++o) { const size_t row = (size_t)(s0 + t0 + wave * 8 + o);
            const float mu = wave_sum_fast(sum4(acc[o])) * (1.f / 256.f); const f32x4 d = acc[o] - mu;
            const float rstd = rsqrtf(wave_sum_fast(sum4(d * d)) * (1.f / 256.f) + EPS);
            const f32x4 z = d * rstd * g1 + b1;
            const f32x4 sw = (f32x4){z.x * sigmoid_fast(z.x), z.y * sigmoid_fast(z.y), z.z * sigmoid_fast(z.z), z.w * sigmoid_fast(z.w)};
            const float r2 = rsqrtf(wave_sum_fast(sum4(sw * sw)) * (1.f / 256.f) + EPS);
            st_bf4(YMIX + row * D + 256 + ch, sw * r2 * g2); }
        __syncthreads();
    }
}

constexpr int VT_STRIDE = 272;
__device__ __forceinline__ void item_C(const bf16_t* __restrict__ P, const float* __restrict__ lg, const float* __restrict__ lb, const bf16_t* __restrict__ Wb  ,
                                       const float* __restrict__ bs  , const float* __restrict__ gg  , bf16_t* __restrict__ YMIX, LAS unsigned char* lds, int r0, int wave, int lane) {
    LAS unsigned char* VT = lds;
    LAS float* hs = (LAS float*)(lds + 256 * VT_STRIDE);
    { const int ch = lane * 4; const f32x4 g1 = *(const f32x4*)(lg + ch), b1 = *(const f32x4*)(lb + ch);
      uint2 raw[16];
#pragma unroll
      for (int i = 0; i < 16; ++i) raw[i] = *(const uint2*)(P + (size_t)(r0 + wave * 16 + i) * INC + OFF_C + 256 + ch);
#pragma unroll
      for (int i = 0; i < 16; ++i) { const int q = wave * 16 + i;
          const f32x4 pv = (f32x4){__uint_as_float(raw[i].x << 16), __uint_as_float(raw[i].x & 0xffff0000u), __uint_as_float(raw[i].y << 16), __uint_as_float(raw[i].y & 0xffff0000u)};
          const f32x4 v = (f32x4){gelu_fast(pv.x), gelu_fast(pv.y), gelu_fast(pv.z), gelu_fast(pv.w)};
          const float mu = wave_sum_fast(sum4(v)) * (1.f / 256.f); const f32x4 d = v - mu;
          const float rstd = rsqrtf(wave_sum_fast(sum4(d * d)) * (1.f / 256.f) + EPS);
          const f32x4 vn = d * rstd * g1 + b1;
          LAS bf16_t* dst = (LAS bf16_t*)(VT + (size_t)ch * VT_STRIDE + q * 2);
          dst[0] = f2bf(vn.x); dst[VT_STRIDE / 2] = f2bf(vn.y); dst[2 * (VT_STRIDE / 2)] = f2bf(vn.z); dst[3 * (VT_STRIDE / 2)] = f2bf(vn.w); } }
    __syncthreads();
    const int h = wave >> 1, ph = wave & 1, l15 = lane & 15, kq = lane >> 4;
    f32x4 acc[4][4];
#pragma unroll
    for (int mi = 0; mi < 4; ++mi)
#pragma unroll
        for (int ni = 0; ni < 4; ++ni) acc[mi][ni] = (f32x4){0.f, 0.f, 0.f, 0.f};
#pragma unroll
    for (int ks = 0; ks < 4; ++ks) {
        bf16x8 af[4], bf[4];
#pragma unroll
        for (int mi = 0; mi < 4; ++mi) af[mi] = *(const LAS bf16x8*)(VT + (size_t)(64 * h + 16 * mi + l15) * VT_STRIDE + (32 * ks + 8 * kq) * 2);
#pragma unroll
        for (int ni = 0; ni < 4; ++ni) bf[ni] = *(const bf16x8*)(Wb + ((size_t)h * 128 + 64 * ph + 16 * ni + l15) * 128 + 32 * ks + 8 * kq);
#pragma unroll
        for (int mi = 0; mi < 4; ++mi)
#pragma unroll
            for (int ni = 0; ni < 4; ++ni) acc[mi][ni] = __builtin_amdgcn_mfma_f32_16x16x32_bf16(af[mi], bf[ni], acc[mi][ni], 0, 0, 0);
    }
    float ssq[4];
#pragma unroll
    for (int ni = 0; ni < 4; ++ni) { const int p = 64 * ph + 16 * ni + l15; const float bsp = bs[h * 128 + p]; float s = 0.f;
#pragma unroll
        for (int mi = 0; mi < 4; ++mi) { const int ch = 64 * h + 16 * mi + 4 * kq; const f32x4 pu = ld_bf4(P + (size_t)(r0 + p) * INC + OFF_C + ch);
            const f32x4 u = (f32x4){gelu_fast(pu.x), gelu_fast(pu.y), gelu_fast(pu.z), gelu_fast(pu.w)};
            acc[mi][ni] = (acc[mi][ni] + bsp) * u; s += sum4(acc[mi][ni] * acc[mi][ni]); }
        s += __shfl_xor(s, 16); s += __shfl_xor(s, 32); ssq[ni] = s;
        if (kq == 0) hs[p * 4 + h] = s; }
    __syncthreads();
#pragma unroll
    for (int ni = 0; ni < 4; ++ni) { const int p = 64 * ph + 16 * ni + l15; const f32x4 t = *(const LAS f32x4*)(hs + p * 4);
        const float rstd = rsqrtf(sum4(t) * (1.f / 256.f) + EPS);
#pragma unroll
        for (int mi = 0; mi < 4; ++mi) { const int ch = 64 * h + 16 * mi + 4 * kq; const f32x4 g2 = *(const f32x4*)(gg + ch);
            st_bf4(YMIX + (size_t)(r0 + p) * D + 512 + ch, acc[mi][ni] * rstd * g2); } }
    __syncthreads();
}

constexpr int KS = 528, VS = 576, KVBUF = 64 * KS + 64 * VS;
constexpr int HS_OFF = 2 * KVBUF;
__device__ __forceinline__ s16x4 trd(const LAS unsigned char* p) { typedef short v4i16_t __attribute__((ext_vector_type(4))); return __builtin_bit_cast(s16x4, __builtin_amdgcn_ds_read_tr16_b64_v4i16((LAS v4i16_t*)p)); }
__device__ __forceinline__ void item_D(const bf16_t* __restrict__ P, const bf16_t* __restrict__ biasT  , const float* __restrict__ gg  ,
                                       bf16_t* __restrict__ YMIX, LAS unsigned char* lds, int qrow0, int b, int gr, int tid, int wave, int lane, int xf) {
    (void)xf;
    const int h = wave >> 1, qh = wave & 1, l31 = lane & 31, hg = lane >> 5;
    const int nloc = gr >= 0 ? 8 : 0, ntile = nloc + 4, kr0 = gr >= 0 ? min(max(gr - 4, 0), GROWS - 8) : 0;
    bf16x8 qf[4];
    { const bf16_t* qp = P + (size_t)(qrow0 + 32 * qh + l31) * INC + OFF_D + 64 * h + 8 * hg;
#pragma unroll
      for (int s = 0; s < 4; ++s) { const u32x4 raw = *(const u32x4*)(qp + 16 * s); u32x4 o;
#pragma unroll
          for (int i = 0; i < 4; ++i) { const float lo = __uint_as_float(raw[i] << 16) * (0.125f * LOG2E), hi = __uint_as_float(raw[i] & 0xffff0000u) * (0.125f * LOG2E); o[i] = cvtpk(lo, hi); }
          qf[s] = __builtin_bit_cast(bf16x8, o); } }
    bf16x8 oh[2];
#pragma unroll
    for (int s = 0; s < 2; ++s)
#pragma unroll
        for (int j = 0; j < 8; ++j) oh[s][j] = (16 * s + 8 * hg + j == l31) ? (short)0x3F80 : (short)0;
    u32x4 kA[4], vA[4];
#define MXD_SRC(j) ((j) < nloc ? (size_t)b * SEQ + (size_t)(kr0 + (j)) * GRID_W : (size_t)MLAT + (size_t)b * NCTX + (size_t)((j) - nloc) * 64)
#define MXD_LOAD(kr_, vr_, j) do { const size_t rb_ = MXD_SRC(j); _Pragma("unroll") for (int i_ = 0; i_ < 4; ++i_) { const int id_ = tid + NTHR * i_, row_ = id_ >> 5, c_ = id_ & 31; \
        const bf16_t* src_ = P + (rb_ + row_) * INC + OFF_KV + 8 * c_; kr_[i_] = *(const u32x4*)src_; vr_[i_] = *(const u32x4*)(src_ + 256); } } while (0)
#define MXD_STORE(kr_, vr_, buf) do { _Pragma("unroll") for (int i_ = 0; i_ < 4; ++i_) { const int id_ = tid + NTHR * i_, row_ = id_ >> 5, c_ = id_ & 31; \
        *(LAS u32x4*)(lds + (buf) * KVBUF + row_ * KS + c_ * 16) = kr_[i_]; *(LAS u32x4*)(lds + (buf) * KVBUF + 64 * KS + row_ * VS + c_ * 16) = vr_[i_]; } } while (0)
    f32x16 o0 = {}, o1 = {}, negm = {};
    float mref = 0.f, lsum = 0.f;
    const int trq = (lane & 15) >> 2, trp = lane & 3, trb = (lane >> 4) & 1;
    bf16x8 bfr[4];
    const bf16_t* btb = biasT + ((((size_t)(h * 15) * 2 + qh) * 4) * 64 + lane) * 8;
#define MXD_BIAS(j) do { const int dr_ = kr0 + (j) - gr + 7; _Pragma("unroll") for (int f_ = 0; f_ < 4; ++f_) bfr[f_] = *(const bf16x8*)(btb + (size_t)dr_ * 4096 + f_ * 512); } while (0)
#define MXD_COMPUTE(j, buf) do { \
        const LAS unsigned char* Kb = lds + (buf) * KVBUF; const LAS unsigned char* Vb = Kb + 64 * KS; \
        bf16x8 ka0[4], ka1[4]; \
        _Pragma("unroll") for (int s = 0; s < 4; ++s) { ka0[s] = *(const LAS bf16x8*)(Kb + l31 * KS + (64 * h + 16 * s + 8 * hg) * 2); ka1[s] = *(const LAS bf16x8*)(Kb + (32 + l31) * KS + (64 * h + 16 * s + 8 * hg) * 2); } \
        f32x16 p0, p1; \
        if ((j) < nloc) { \
            p0 = __builtin_amdgcn_mfma_f32_32x32x16_bf16(bfr[0], oh[0], negm, 0, 0, 0); p1 = __builtin_amdgcn_mfma_f32_32x32x16_bf16(bfr[2], oh[0], negm, 0, 0, 0); \
            p0 = __builtin_amdgcn_mfma_f32_32x32x16_bf16(bfr[1], oh[1], p0, 0, 0, 0); p1 = __builtin_amdgcn_mfma_f32_32x32x16_bf16(bfr[3], oh[1], p1, 0, 0, 0); \
            if ((j) + 1 < nloc) MXD_BIAS((j) + 1); \
        } else { p0 = negm; p1 = negm; } \
        _Pragma("unroll") for (int s = 0; s < 4; ++s) { p0 = __builtin_amdgcn_mfma_f32_32x32x16_bf16(ka0[s], qf[s], p0, 0, 0, 0); p1 = __builtin_amdgcn_mfma_f32_32x32x16_bf16(ka1[s], qf[s], p1, 0, 0, 0); } \
          \
        s16x4 vf[16]; \
        _Pragma("unroll") for (int kb = 0; kb < 2; ++kb) _Pragma("unroll") for (int s = 0; s < 2; ++s) { \
            const LAS unsigned char* vp = Vb + (32 * kb + 16 * s + 4 * hg + trq) * VS + (64 * h + 16 * trb + 4 * trp) * 2; \
            vf[(kb * 2 + s) * 4 + 0] = trd(vp); vf[(kb * 2 + s) * 4 + 1] = trd(vp + 8 * VS); vf[(kb * 2 + s) * 4 + 2] = trd(vp + 64); vf[(kb * 2 + s) * 4 + 3] = trd(vp + 8 * VS + 64); } \
          \
        float mt = fmaxf(p0[0], p1[0]); \
        _Pragma("unroll") for (int r = 1; r < 16; ++r) mt = fmaxf(mt, fmaxf(p0[r], p1[r])); \
        { const auto rr_ = __builtin_amdgcn_permlane32_swap(__float_as_uint(mt), __float_as_uint(mt), false, false); mt = fmaxf(__uint_as_float(rr_[0]), __uint_as_float(rr_[1])); } \
        if ((j) == 0 || __any(mt > 8.f)) { \
            const float d_ = (j) == 0 ? mt : fmaxf(mt, 0.f); mref += d_; \
            _Pragma("unroll") for (int r = 0; r < 16; ++r) { p0[r] -= d_; p1[r] -= d_; } \
            const float al_ = __builtin_amdgcn_exp2f(-d_); lsum *= al_; \
            _Pragma("unroll") for (int r = 0; r < 16; ++r) { o0[r] *= al_; o1[r] *= al_; negm[r] = -mref; } \
        } \
        float ps = 0.f; \
        _Pragma("unroll") for (int r = 0; r < 16; ++r) { p0[r] = __builtin_amdgcn_exp2f(p0[r]); p1[r] = __builtin_amdgcn_exp2f(p1[r]); ps += p0[r] + p1[r]; } \
        lsum += ps; \
        _Pragma("unroll") for (int kb = 0; kb < 2; ++kb) _Pragma("unroll") for (int s = 0; s < 2; ++s) { \
                u32x4 pw; \
                _Pragma("unroll") for (int i = 0; i < 4; ++i) pw[i] = kb == 0 ? cvtpk(p0[8 * s + 2 * i], p0[8 * s + 2 * i + 1]) : cvtpk(p1[8 * s + 2 * i], p1[8 * s + 2 * i + 1]); \
                const bf16x8 pf = __builtin_bit_cast(bf16x8, pw); \
                const s16x4 a00 = vf[(kb * 2 + s) * 4 + 0], a01 = vf[(kb * 2 + s) * 4 + 1], a10 = vf[(kb * 2 + s) * 4 + 2], a11 = vf[(kb * 2 + s) * 4 + 3]; \
                const bf16x8 v0 = (bf16x8){a00[0], a00[1], a00[2], a00[3], a01[0], a01[1], a01[2], a01[3]}; \
                const bf16x8 v1 = (bf16x8){a10[0], a10[1], a10[2], a10[3], a11[0], a11[1], a11[2], a11[3]}; \
                o0 = __builtin_amdgcn_mfma_f32_32x32x16_bf16(v0, pf, o0, 0, 0, 0); o1 = __builtin_amdgcn_mfma_f32_32x32x16_bf16(v1, pf, o1, 0, 0, 0); } \
    } while (0)
    MXD_LOAD(kA, vA, 0);
    if (nloc) MXD_BIAS(0);
    MXD_STORE(kA, vA, 0);
    __syncthreads();
    for (int j = 0; j < ntile; ++j) {
        const int buf = j & 1;
        if (j + 1 < ntile) MXD_LOAD(kA, vA, j + 1);
        MXD_COMPUTE(j, buf);
        if (j + 1 < ntile) MXD_STORE(kA, vA, buf ^ 1);
        __syncthreads();
    }
#undef MXD_SRC
#undef MXD_LOAD
#undef MXD_STORE
#undef MXD_BIAS
#undef MXD_COMPUTE
    { const auto rr_ = __builtin_amdgcn_permlane32_swap(__float_as_uint(lsum), __float_as_uint(lsum), false, false); lsum = __uint_as_float(rr_[0]) + __uint_as_float(rr_[1]); }
    const float inv = __builtin_amdgcn_rcpf(lsum);
    float ssq = 0.f;
#pragma unroll
    for (int r = 0; r < 16; ++r) { o0[r] *= inv; o1[r] *= inv; ssq += o0[r] * o0[r] + o1[r] * o1[r]; }
    { const auto rr_ = __builtin_amdgcn_permlane32_swap(__float_as_uint(ssq), __float_as_uint(ssq), false, false); ssq = __uint_as_float(rr_[0]) + __uint_as_float(rr_[1]); }
    LAS float* hs = (LAS float*)(lds + HS_OFF);
    const int q = 32 * qh + l31;
    if (hg == 0) hs[q * 4 + h] = ssq;
    __syncthreads();
    const f32x4 t4 = *(const LAS f32x4*)(hs + q * 4);
    const float rstd = rsqrtf(sum4(t4) * (1.f / 256.f) + EPS);
    bf16_t* orow = YMIX + (size_t)(qrow0 + q) * D + 768 + 64 * h;
#pragma unroll
    for (int c = 0; c < 2; ++c)
#pragma unroll
        for (int r4 = 0; r4 < 4; ++r4) { const int d = 32 * c + 8 * r4 + 4 * hg; const f32x4 g2 = *(const f32x4*)(gg + 64 * h + d);
            const f32x4 v = c == 0 ? (f32x4){o0[4 * r4], o0[4 * r4 + 1], o0[4 * r4 + 2], o0[4 * r4 + 3]} : (f32x4){o1[4 * r4], o1[4 * r4 + 1], o1[4 * r4 + 2], o1[4 * r4 + 3]};
            st_bf4(orow + d, v * rstd * g2); }
    __syncthreads();
}

__device__ __forceinline__ void build_tables(const float* __restrict__ sgu_w, const float* __restrict__ rpb, bf16_t* __restrict__ Wb, bf16_t* __restrict__ biasT, int gtid, int ngt) {
    for (int i = gtid; i < 2 * 4 * 128 * 128; i += ngt) Wb[i] = f2bf(sgu_w[i]);
    for (int i = gtid; i < 2 * 4 * 15 * 2 * 2 * 2 * 64 * 8; i += ngt) {
        const int j = i & 7, lane = (i >> 3) & 63, s = (i >> 9) & 1, kb = (i >> 10) & 1, qh = (i >> 11) & 1; int r = i >> 12; const int dr = r % 15; r /= 15; const int h = r & 3, l = r >> 2;
        const int kc = 32 * kb + (lane & 31), qc = 32 * qh + 16 * s + 8 * (lane >> 5) + j, c0 = min(max(qc - 8, 0), GRID_W - 16);
        const bool ok = kc >= c0 && kc < c0 + 16;
        biasT[i] = f2bf(ok ? rpb[((l * 4 + h) * 15 + dr) * 31 + (kc - qc + 15)] * LOG2E : -1e30f);
    }
}
__device__ __forceinline__ void phase(const bf16_t* __restrict__ P, bf16_t* __restrict__ YMIX, const KArgs& a, unsigned char* ws, LAS unsigned char* lds, int l, int vcu, int G, int tid, int wave, int lane0) {
    (void)lane0;
    const int nt128 = (l == 0 ? MT : MLAT) / 128;
    const int nD = 2 * GROWS, nDc = l == 0 ? MCTX / 64 : 0;
    const int total = nD + nDc + 3 * nt128;
    const float* gg = a.in[IN_GG] + l * D;
    const bf16_t* biasT = (const bf16_t*)(ws + WS_BIAS) + (size_t)l * (4 * 15 * 2 * 2 * 2 * 64 * 8);
    const bf16_t* Wb = (const bf16_t*)(ws + WS_SGUW) + (size_t)l * 4 * 128 * 128;
    const int nit = vcu < total ? (total - vcu + G - 1) / G : 0, rot = (a.flags & 4) ? 0 : (vcu >> 3) % (nit > 0 ? nit : 1);
    for (int kk = 0; kk < nit; ++kk) {
        const int it = vcu + ((kk + rot) % nit) * G;
        int r = it;
        asm volatile("" : "+v"(tid));
        const int lane = tid & 63;
        if (r < nD) { const int b = r / GROWS, gr = r % GROWS; if (MX_D && !(a.flags & 128)) item_D(P, biasT, gg + 768, YMIX, lds, b * SEQ + gr * GRID_W, b, gr, tid, wave, lane, a.flags >> 8); continue; }
        r -= nD;
        if (r < nDc) { const int b = r / (NCTX / 64), i = r % (NCTX / 64); if (MX_D && !(a.flags & 128)) item_D(P, biasT, gg + 768, YMIX, lds, MLAT + b * NCTX + i * 64, b, -1, tid, wave, lane, a.flags >> 8); continue; }
        r -= nDc;
        if (r < nt128) { if (MX_C && !(a.flags & 64)) item_C(P, a.in[IN_SLG] + l * 256, a.in[IN_SLB] + l * 256, Wb, a.in[IN_SGB] + l * 4 * 128, gg + 512, YMIX, lds, r * 128, wave, lane); continue; }
        r -= nt128;
        if (r < nt128) { if (MX_B && !(a.flags & 32)) item_B(P, a.in[IN_CBW] + l * 31 * 256, a.in[IN_CBB] + l * 256, a.in[IN_CLG] + l * 256, a.in[IN_CLB] + l * 256, gg + 256, YMIX, lds, r * 128, wave, lane); continue; }
        r -= nt128;
        if (MX_A && !(a.flags & 16)) item_A(P, a.in[IN_CAW] + l * 3 * 256, gg, YMIX, r * 128, wave, lane);
    }
}
}

#ifndef CQ_G10
#define CQ_G10 11500
#define CQ_G20 12000
#define CQ_F10 10500
#define CQ_F20 9008
#endif
#ifndef GEMM_ALIGN
#define GEMM_ALIGN true
#endif
__global__ void __launch_bounds__(NTHR, 2) mk_fwd(KArgs a) {
    extern __shared__ __attribute__((aligned(16))) unsigned char lds_raw[];
    LAS unsigned char* lds = (LAS unsigned char*)lds_raw;
    volatile LAS unsigned* MISC = (volatile LAS unsigned*)(lds + MISC_OFF);
    const LAS unsigned* gtab = (const LAS unsigned*)(lds + GTAB_OFF);
    const int tid0 = threadIdx.x;
    const int wave0 = __builtin_amdgcn_readfirstlane(tid0 >> 6);
    const int G = gridDim.x, blk = blockIdx.x;
    const int vcu = (G % 8 == 0) ? (blk % 8) * (G / 8) + blk / 8 : blk;
    const int ngw = G * NWAVES;
    for (int u = tid0; u < 128; u += NTHR) MISC[u] = 0u;
    __syncthreads();
    unsigned char* ws0 = a.ws;
#define PH_ENTER() int wv_ = wave0; size_t wso_ = 0; asm volatile("" : "+s"(wv_), "+s"(wso_)); int tid = wv_ * 64 + (int)__builtin_amdgcn_mbcnt_hi(~0u, __builtin_amdgcn_mbcnt_lo(~0u, 0u)); asm volatile("" : "+v"(tid)); unsigned char* ws = ws0 + wso_;     const int lane = tid & 63, wave = __builtin_amdgcn_readfirstlane(tid >> 6), gw = vcu * NWAVES + wave; \
    float* mod = (float*)(ws + WS_MOD); float* xc = (float*)(ws + WS_XC); float* xl = a.out; bf16_t* H = (bf16_t*)(ws + WS_H); bf16_t* P = (bf16_t*)(ws + WS_P); bf16_t* Gb = (bf16_t*)(ws + WS_G); bf16_t* YMIX = (bf16_t*)(ws + WS_YMIX); \
    const float* modl = mod + l * 3 * MODW; const float* xl_in = l == 0 ? a.in[IN_X] : xl; const float* xc_in = l == 0 ? a.in[IN_CTX] : xc; \
    (void)lane; (void)wave; (void)gw; (void)mod; (void)xc; (void)xl; (void)H; (void)P; (void)Gb; (void)YMIX; (void)modl; (void)xl_in; (void)xc_in
    XcdBarrier bar = xcd_barrier_post((unsigned*)(ws0 + WS_CTL) + CW_BAR + a.li * XCD_BAR_WORDS, MISC + 8);
    const int lo = a.ph_lo, hi = a.ph_hi;
#define IN(k) (lo <= (k) && (k) < hi)
#define SPARE(nwg_) ((nwg_) % G != 0 && blk >= (nwg_) % G)
#define CONVERT_SHARE(nwg_, i0_, i1_, per_level_, POST_) do { if (SPARE(nwg_) && !(a.flags & 1)) { const int r_ = (nwg_) % G, nidle_ = G - r_, k_ = blk - r_; \
        LAS float* scr_ = (LAS float*)(lds + wave * 16384); for (int it_ = IT_DENSE + (i0_) + k_ * NWAVES + wave; it_ < IT_DENSE + (i1_); it_ += nidle_ * NWAVES) conv_item(a, ws, it_, scr_, lane); } } while (0)
    constexpr int TC1 = CQ_G10, TC2 = TC1 + CQ_G20, TC3 = TC2 + CQ_F10, TC4 = TC3 + CQ_F20;
    static_assert(TC4 <= IT_MOE, "conversion quotas");
#define SEAM(k) do { if (IN(k) && IN((k) + 1)) xcd_barrier(bar); } while (0)

    if (IN(PH_PRO)) { const int l = 0; PH_ENTER();
        ph_convert(a, ws, lds, 0, IT_DENSE, gw, ngw, wave, lane);
        ph_mod(a, ws, lds, blk, G, tid, wave, lane);
#if MIXER_FAST
        mx::build_tables(a.in[IN_SGW], a.in[IN_RPB], (bf16_t*)(ws + WS_SGUW), (bf16_t*)(ws + WS_BIAS), gw * 64 + lane, ngw * 64);
#endif
    }
    SEAM(PH_PRO);

    for (int l = 0; l < 2; ++l) {
        const int pb = l == 0 ? PH_N1_0 : PH_N1_1;
        const int ph_g2 = l == 0 ? PH_G2_0 : PH_G2_1;
        if (IN(pb)) { PH_ENTER(); ph_norm(xl_in, xc_in, a.in[IN_N1G] + l * D, modl, 0, 1, H, MT, gw, ngw, lane, l == 1 ? (const float*)(ws + WS_SLAB0) : nullptr, mod + 2 * MODW + 5 * D); }
        SEAM(pb);
        if (IN(pb + 1)) { PH_ENTER();
            pg8::Gemm g{H, (const bf16_t*)(ws + WS_WIN) + (size_t)l * INC * D, 0, MT, INC, D}; pg8::StaticOrder S; S.init(MT, INC, G, blk);
            pg8::EpiStoreBf16 E{P, INC};
            constexpr int NWG1 = (MT / 256) * (INC / 256);
            pg8::gemm_phase<pg8::EpiStoreBf16, pg8::StaticOrder, false, GEMM_ALIGN>(lds, gtab, g, S, E, tid);
            if (l == 0) CONVERT_SHARE(NWG1, 0, TC1, 1, true); else CONVERT_SHARE(NWG1, TC4, IT_MOE, 1, true);
        }
        SEAM(pb + 1);
        if (IN(pb + 2)) {
#if MIXER_NAIVE_INKERNEL
            const int r1 = l == 1 ? MLAT : MT;
            { PH_ENTER(); float* YRAW = (float*)(ws + WS_YRAW); float* TMPB = (float*)(ws + WS_TMP); float* TMPC = (float*)(ws + WS_TMP2);
              const int vb0 = 2 * blk + (tid >> 8), nvb = 2 * G, ch = tid & 255;
              nv_mixA(P, a.in[IN_CAW] + l * 3 * 256, YRAW, r1, vb0, nvb, ch);
              nv_mixB1(P, a.in[IN_CBW] + l * 31 * 256, a.in[IN_CBB] + l * 256, TMPB, r1, vb0, nvb, ch);
              nv_ln256<1>(nullptr, P, a.in[IN_SLG] + l * 256, a.in[IN_SLB] + l * 256, TMPC, r1, gw, ngw, lane);
              nv_attn(P, a.in[IN_RPB] + l * 4 * 15 * 31, YRAW, r1, gw, ngw, lane, (LAS float*)(lds + wave * 2048)); }
            xcd_barrier(bar);
            { PH_ENTER(); float* YRAW = (float*)(ws + WS_YRAW); float* TMPB = (float*)(ws + WS_TMP); float* TMPC = (float*)(ws + WS_TMP2);
              const int vb0 = 2 * blk + (tid >> 8), nvb = 2 * G, ch = tid & 255;
              nv_ln256<0>(TMPB, P, a.in[IN_CLG] + l * 256, a.in[IN_CLB] + l * 256, YRAW, r1, gw, ngw, lane);
              nv_mixC2(P, TMPC, a.in[IN_SGW] + (size_t)l * 4 * 128 * 128, a.in[IN_SGB] + l * 4 * 128, YRAW, r1, vb0, nvb, ch); }
            xcd_barrier(bar);
            { PH_ENTER(); float* YRAW = (float*)(ws + WS_YRAW);
              nv_groupnorm(YRAW, a.in[IN_GG] + l * D, YMIX, r1, gw, ngw, lane); }
#if MIXER_FAST
            xcd_barrier(bar);
#endif
#endif
#if MIXER_FAST
            { PH_ENTER(); mx::phase(P, YMIX, a, ws, lds, l, vcu, G, tid, wave, lane); }
#endif
        }
        SEAM(pb + 2);
        if (l == 1) {
            if (IN(PH_MOECONV) && (a.flags & 1)) { PH_ENTER(); ph_convert(a, ws, lds, IT_DENSE, IT_DENSE + IT_MOE, gw, ngw, wave, lane); }
            SEAM(PH_MOECONV);
        }
        if (IN(ph_g2)) { PH_ENTER();
            const int rows = l == 0 ? MT : MLAT;
            pg8::Gemm g{YMIX, (const bf16_t*)(ws + WS_WOUT) + (size_t)l * D * D, 0, rows, D, D}; pg8::StaticOrder S; S.init(rows, D, G, blk);
            pg8::EpiResid E{xl_in, xc_in, xl, xc, modl + 2 * D, nullptr};
            constexpr int NWG2 = (MT / 256) * (D / 256);
            pg8::gemm_phase<pg8::EpiResid, pg8::StaticOrder, false, GEMM_ALIGN>(lds, gtab, g, S, E, tid);
            if (l == 0) CONVERT_SHARE(NWG2, TC1, TC2, 1, true);
        }
        SEAM(ph_g2);
        if (l == 0) {
            if (IN(PH_N2_0)) { PH_ENTER(); ph_norm(xl, xc, a.in[IN_N2G] + l * D, modl, 3, 4, H, MT, gw, ngw, lane); }
            SEAM(PH_N2_0);
            if (IN(PH_F1_0)) { PH_ENTER();
                pg8::Gemm g{H, (const bf16_t*)(ws + WS_W13), 0, MT, 2 * DFF, D}; pg8::StaticOrder S; S.init(MT, 2 * DFF, G, blk);
                pg8::EpiSwiglu E{Gb, DFF};
                constexpr int NWF1 = (MT / 256) * (2 * DFF / 256);
                pg8::gemm_phase<pg8::EpiSwiglu, pg8::StaticOrder, false, GEMM_ALIGN>(lds, gtab, g, S, E, tid);
                CONVERT_SHARE(NWF1, TC2, TC3, 1, true);
            }
            SEAM(PH_F1_0);
            if (IN(PH_F2_0)) { PH_ENTER();
                pg8::Gemm g{Gb, (const bf16_t*)(ws + WS_W2), 0, MT, D, DFF}; pg8::DenseTailOrder S; S.init(MLAT, D, G, blk, MCTX / 256, F2_SPLITK, F2_NKT);
                pg8::EpiResid E{xl, xc, xl, xc, modl + 5 * D, (float*)(ws + WS_SLAB0)};
                pg8::gemm_phase<pg8::EpiResid, pg8::DenseTailOrder, false, GEMM_ALIGN>(lds, gtab, g, S, E, tid);
                constexpr int NWF2 = (MCTX / 256) * (D / 256) * F2_SPLITK;
                CONVERT_SHARE(NWF2, TC3, TC4, 2, true);
            }
            SEAM(PH_F2_0);
        } else {
            if (IN(PH_RT)) { PH_ENTER(); ph_route(a, ws, lds, xl, a.in[IN_N2G] + l * D, modl, blk, tid, wave, lane); }
            SEAM(PH_RT);
            if (IN(PH_PLAN)) { PH_ENTER(); ph_plan(ws, lds, blk, tid); }
            SEAM(PH_PLAN);
            for (int pass = 0; pass < 2; ++pass) {
                const int ph1 = pass == 0 ? PH_M1A : PH_M1B;
                if (IN(ph1)) { PH_ENTER(); const int* ebase = (const int*)(ws + WS_SLOT + SLOT_EBASE); const int* slot_tok = (const int*)(ws + WS_SLOT + SLOT_TOK);
                    pg8::GroupedOrder S; S.init(ebase + pass * 9, 2 * DFE, G, blk);
                    { pg8::Unit u; LAS unsigned* gt = (LAS unsigned*)(lds + GTAB_OFF);
                      for (int i = 0; i < 16 && S.next(i, u); ++i) if (tid < 256) { const int tok = slot_tok[pass * PASS_ROWS + u.pm * 256 + tid]; gt[i * 256 + tid] = (unsigned)(tok < 0 ? 0 : tok) * (unsigned)(D * 2); } }
                    __syncthreads();
                    pg8::Gemm g{H, (const bf16_t*)(ws + WS_MW13), (size_t)2 * DFE * D * 2, 0, 2 * DFE, D};
                    pg8::EpiSwiglu E{Gb, DFE};
                    pg8::gemm_phase<pg8::EpiSwiglu, pg8::GroupedOrder, true, GEMM_ALIGN>(lds, gtab, g, S, E, tid);
                }
                SEAM(ph1);
                if (IN(ph1 + 1)) { PH_ENTER(); const int* ebase = (const int*)(ws + WS_SLOT + SLOT_EBASE); const int* slot_tok = (const int*)(ws + WS_SLOT + SLOT_TOK); const float* slot_gate = (const float*)(ws + WS_SLOT + SLOT_GATE);
                    pg8::GroupedTailOrder S; S.init(ebase + pass * 9, D, G, blk);
                    pg8::Gemm g{Gb, (const bf16_t*)(ws + WS_MW2), (size_t)D * DFE * 2, 0, D, DFE};
                    pg8::EpiMoeDown E{xl, slot_tok + pass * PASS_ROWS, slot_gate + pass * PASS_ROWS, modl + 5 * D, (float*)(ws + (pass == 0 ? WS_SLAB0 : WS_H))};
                    pg8::gemm_phase<pg8::EpiMoeDown, pg8::GroupedTailOrder, false, GEMM_ALIGN>(lds, gtab, g, S, E, tid);
                }
                SEAM(ph1 + 1);
            }
            if (IN(PH_FIN)) { PH_ENTER(); ph_final(xl, a.in[IN_FG], ws, modl + 5 * D, gw, ngw, lane); }
        }
    }
#undef IN
#undef SEAM
}

extern "C" void kernel_launch(void* const* d_in, const int* in_sizes, int n_in, void* d_out, int out_size, void* d_ws, size_t ws_size, hipStream_t stream) {
    static int ready = 0;
    if (ready == 0) {
        ready = -1;
        if (n_in != 30 || out_size != MLAT * D || in_sizes[0] != MLAT * D || ws_size < WS_END) { fprintf(stderr, "kernel_launch: unexpected shapes / workspace (%d inputs, out %d, ws %zu)\n", n_in, out_size, ws_size); return; }
        int dev = 0, cus = 0;
        if (hipGetDevice(&dev) != hipSuccess || hipDeviceGetAttribute(&cus, hipDeviceAttributeMultiprocessorCount, dev) != hipSuccess) return;
        if (cus < NBLK) { fprintf(stderr, "kernel_launch: needs %d CUs, device has %d\n", NBLK, cus); return; }
        if (hipFuncSetAttribute((const void*)mk_fwd, hipFuncAttributeMaxDynamicSharedMemorySize, LDS_BYTES) != hipSuccess) { fprintf(stderr, "kernel_launch: hipFuncSetAttribute failed\n"); return; }
        int per_cu = 0;
        if (hipOccupancyMaxActiveBlocksPerMultiprocessor(&per_cu, (const void*)mk_fwd, NTHR, LDS_BYTES) != hipSuccess || per_cu < 1) { fprintf(stderr, "kernel_launch: occupancy query says %d blocks per CU\n", per_cu); (void)hipGetLastError(); return; }
        ready = 1;
    }
    if (ready < 0) return;
    (void)hipMemsetAsync((char*)d_ws + WS_CTL, 0, CTL_ZERO_BYTES, stream);
    KArgs a{};
    for (int i = 0; i < 30; ++i) a.in[i] = (const float*)d_in[i];
    a.out = (float*)d_out; a.ws = (unsigned char*)d_ws;
#if HYBRID
    unsigned char* ws = (unsigned char*)d_ws;
    bf16_t* P = (bf16_t*)(ws + WS_P); bf16_t* YMIX = (bf16_t*)(ws + WS_YMIX); float* YRAW = (float*)(ws + WS_YRAW); float* TMP = (float*)(ws + WS_TMP);
    a.flags = 1;
    const int cuts[4] = {PH_PRO, PH_MIX_0, PH_MIX_1, PH_COUNT};
    for (int li = 0; li < 3; ++li) {
        a.ph_lo = li == 0 ? cuts[0] : cuts[li] + 1; a.ph_hi = cuts[li + 1]; a.li = li;
        hipLaunchKernelGGL(mk_fwd, dim3(NBLK), dim3(NTHR), LDS_BYTES, stream, a);
        if (li < 2) {
            const int l = li; const int r1 = l == 1 ? MLAT : MT;
            k_mixA<<<r1, 256, 0, stream>>>(P, a.in[IN_CAW] + l * 3 * 256, YRAW, 0, r1);
            k_mixB1<<<r1, 256, 0, stream>>>(P, a.in[IN_CBW] + l * 31 * 256, a.in[IN_CBB] + l * 256, TMP, 0, r1);
            k_ln256<0><<<r1 / 4, 256, 0, stream>>>(TMP, P, a.in[IN_CLG] + l * 256, a.in[IN_CLB] + l * 256, YRAW, 0, r1);
            k_ln256<1><<<r1 / 4, 256, 0, stream>>>(nullptr, P, a.in[IN_SLG] + l * 256, a.in[IN_SLB] + l * 256, TMP, 0, r1);
            k_mixC2<<<r1, 256, 0, stream>>>(P, TMP, a.in[IN_SGW] + (size_t)l * 4 * 128 * 128, a.in[IN_SGB] + l * 4 * 128, YRAW, 0, r1);
            k_attn<<<r1, 256, 0, stream>>>(P, a.in[IN_RPB] + l * 4 * 15 * 31, YRAW, 0, r1);
            k_groupnorm<<<r1, 256, 0, stream>>>(YRAW, a.in[IN_GG] + l * D, YMIX, 0, r1);
        }
    }
#elif defined(PROBE_PHASE)
    a.flags = 0; int li = 0;
    a.ph_lo = 0; a.ph_hi = PROBE_PHASE + 1; a.li = li++; hipLaunchKernelGGL(mk_fwd, dim3(NBLK), dim3(NTHR), LDS_BYTES, stream, a);
    a.flags = PROBE_FLAGS; for (int r = 0; r < PROBE_REPS; ++r) { a.ph_lo = PROBE_PHASE; a.ph_hi = PROBE_PHASE + 1; a.li = li++; hipLaunchKernelGGL(mk_fwd, dim3(NBLK), dim3(NTHR), LDS_BYTES, stream, a); }
    a.flags = 0; a.ph_lo = PROBE_PHASE + 1; a.ph_hi = PH_COUNT; a.li = li++; hipLaunchKernelGGL(mk_fwd, dim3(NBLK), dim3(NTHR), LDS_BYTES, stream, a);
#else
    a.flags = MIXER_NAIVE_INKERNEL ? 1 : 0; a.ph_lo = 0; a.ph_hi = PH_COUNT; a.li = 0;
    hipLaunchKernelGGL(mk_fwd, dim3(NBLK), dim3(NTHR), LDS_BYTES, stream, a);
#endif
}
```

```cpp
#include <hip/hip_runtime.h>
#include <stdint.h>
#include <stdio.h>

#ifndef MIXER_NAIVE_INKERNEL
#define MIXER_NAIVE_INKERNEL 0
#endif
#ifndef MIXER_FAST
#define MIXER_FAST 1
#endif
#ifndef HYBRID
#define HYBRID 0
#endif

constexpr int D = 1024, BATCH = 2, SEQ = 16384, NCTX = 256;
constexpr int MLAT = BATCH * SEQ;
constexpr int MCTX = BATCH * NCTX;
constexpr int MT = MLAT + MCTX;
constexpr int INC = 2560;
constexpr int OFF_A = 0, OFF_B = 768, OFF_C = 1280, OFF_D = 1792, OFF_KV = 2048;
constexpr int DFF = 2816, NEXP = 8, DFE = 3584;
constexpr int GRID_W = 64, GROWS = SEQ / GRID_W;
constexpr float EPS = 1e-6f;
constexpr int MODW = 6 * D;
constexpr int PASS_ROWS = MLAT + NEXP * 256;
constexpr int NBLK = 256;
constexpr int NTHR = 512, NWAVES = 8;

typedef unsigned short bf16_t;
#define LAS __attribute__((address_space(3)))
#define GAS __attribute__((address_space(1)))
__device__ __forceinline__ float bf2f(bf16_t u) { return __uint_as_float(((unsigned)u) << 16); }
__device__ __forceinline__ bf16_t f2bf(float f) { unsigned u = __float_as_uint(f); return (bf16_t)((u + 0x7fffu + ((u >> 16) & 1u)) >> 16); }
__device__ __forceinline__ unsigned pk2(float lo, float hi) { return (unsigned)f2bf(lo) | ((unsigned)f2bf(hi) << 16); }
__device__ __forceinline__ float wave_sum(float v) {
#pragma unroll
    for (int o = 1; o < 64; o <<= 1) v += __shfl_xor(v, o);
    return v;
}
__device__ __forceinline__ float wave_max(float v) {
#pragma unroll
    for (int o = 1; o < 64; o <<= 1) v = fmaxf(v, __shfl_xor(v, o));
    return v;
}
__device__ __forceinline__ float silu_f(float x) { return x / (1.f + __expf(-x)); }
__device__ __forceinline__ float sigmoid_f(float x) { return 1.f / (1.f + __expf(-x)); }
__device__ __forceinline__ float gelu_tanh_f(float x) { const float u = 0.7978845608028654f * (x + 0.044715f * x * x * x); return 0.5f * x * (1.f + tanhf(u)); }
__device__ __forceinline__ int row_modset(int r) { return r < MLAT ? r / SEQ : 2; }
__device__ __forceinline__ void row_seq(int r, int& s0, int& len) {
    if (r < MLAT) { s0 = (r / SEQ) * SEQ; len = SEQ; } else { s0 = MLAT + ((r - MLAT) / NCTX) * NCTX; len = NCTX; }
}

constexpr size_t MiB = 1ull << 20;
constexpr size_t WS_CTL = 0, CTL_ZERO_BYTES = 1 * MiB;
constexpr size_t WS_MOD = 1 * MiB;
constexpr size_t WS_XC = 2 * MiB;
constexpr size_t WS_SEL = 4 * MiB;
constexpr size_t WS_SLOT = 5 * MiB;
constexpr size_t WS_SGUW = 6 * MiB;
constexpr size_t WS_BIAS = 7 * MiB;
constexpr size_t WS_H = 8 * MiB;
constexpr size_t WS_P = 74 * MiB;
constexpr size_t WS_G = 74 * MiB;
constexpr size_t WS_YMIX = 240 * MiB;
constexpr size_t WS_WIN = 312 * MiB;
constexpr size_t WS_WOUT = 322 * MiB;
constexpr size_t WS_W13 = 326 * MiB;
constexpr size_t WS_W2 = 337 * MiB;
constexpr size_t WS_MW13 = 344 * MiB;
constexpr size_t WS_MW2 = 456 * MiB;
constexpr size_t WS_SLAB0 = 512 * MiB;
constexpr size_t WS_TMP2 = 507 * MiB;
constexpr size_t WS_END = 568 * MiB;
constexpr size_t WS_YRAW = 344 * MiB;
constexpr size_t WS_TMP = 474 * MiB;
static_assert(WS_G + (size_t)PASS_ROWS * DFE * 2 <= WS_WIN && WS_YMIX + (size_t)MT * D * 2 <= WS_WIN && WS_P + (size_t)MT * INC * 2 <= WS_YMIX, "ws map");
static_assert(WS_TMP + (size_t)MT * 256 * 4 <= WS_END, "ws map hybrid");
constexpr size_t SEL_E = 0, SEL_G = (size_t)MLAT * 2 * 4, SEL_R = (size_t)MLAT * 4 * 4, SEL_S = (size_t)MLAT * 6 * 4;
constexpr size_t SLOT_TOK = 0, SLOT_GATE = (size_t)2 * PASS_ROWS * 4, SLOT_HIST = (size_t)4 * PASS_ROWS * 4, SLOT_EBASE = SLOT_HIST + 256 * 16 * 4;
static_assert(SEL_S + (size_t)MLAT * 2 * 4 <= 1 * MiB && SLOT_EBASE + 256 <= 1 * MiB, "route map");
constexpr int CW_BAR = 4096;

constexpr int RING_BYTES = 131072;
constexpr int GTAB_OFF = RING_BYTES, GTAB_BYTES = 16384;
constexpr int MISC_OFF = GTAB_OFF + GTAB_BYTES;
constexpr int LDS_BYTES = MISC_OFF + 512;
#if HYBRID
__global__ void k_mixA(const bf16_t* __restrict__ P, const float* __restrict__ wA  , float* __restrict__ YRAW, int r0, int r1) {
    const int idx = blockIdx.x * 256 + threadIdx.x; const int row = r0 + idx / 256, ch = idx % 256;
    if (row >= r1) return;
    int s0, len; row_seq(row, s0, len); const int t = row - s0;
    float acc = 0.f;
    for (int j = 0; j < 3; ++j) { const int tt = t + j - 1; if (tt < 0 || tt >= len) continue;
        const bf16_t* pr = P + (size_t)(s0 + tt) * INC + OFF_A; acc += wA[j * 256 + ch] * (bf2f(pr[256 + ch]) * bf2f(pr[512 + ch])); }
    YRAW[(size_t)row * D + ch] = bf2f(P[(size_t)row * INC + OFF_A + ch]) * acc;
}
__global__ void k_mixB1(const bf16_t* __restrict__ P, const float* __restrict__ wB  , const float* __restrict__ bB, float* __restrict__ TMP, int r0, int r1) {
    const int idx = blockIdx.x * 256 + threadIdx.x; const int row = r0 + idx / 256, ch = idx % 256;
    if (row >= r1) return;
    int s0, len; row_seq(row, s0, len); const int t = row - s0;
    float acc = bB[ch];
    for (int j = 0; j < 31; ++j) { const int tt = t + j - 15; if (tt < 0 || tt >= len) continue;
        const bf16_t* pr = P + (size_t)(s0 + tt) * INC + OFF_B; acc += wB[j * 256 + ch] * (bf2f(pr[ch]) * sigmoid_f(bf2f(pr[256 + ch]))); }
    TMP[(size_t)row * 256 + ch] = acc;
}
template <int MODE> __global__ void k_ln256(const float* __restrict__ TMPin, const bf16_t* __restrict__ P, const float* __restrict__ g, const float* __restrict__ b, float* __restrict__ dst, int r0, int r1) {
    const int lane = threadIdx.x & 63; const int row = r0 + blockIdx.x * 4 + (threadIdx.x >> 6);
    if (row >= r1) return;
    float v[4];
#pragma unroll
    for (int i = 0; i < 4; ++i) { const int ch = lane * 4 + i; v[i] = MODE == 0 ? TMPin[(size_t)row * 256 + ch] : gelu_tanh_f(bf2f(P[(size_t)row * INC + OFF_C + 256 + ch])); }
    const float mu = wave_sum(v[0] + v[1] + v[2] + v[3]) * (1.f / 256.f);
    float q = 0.f;
#pragma unroll
    for (int i = 0; i < 4; ++i) { v[i] -= mu; q += v[i] * v[i]; }
    const float rstd = rsqrtf(wave_sum(q) * (1.f / 256.f) + EPS);
#pragma unroll
    for (int i = 0; i < 4; ++i) { const int ch = lane * 4 + i; const float y = v[i] * rstd * g[ch] + b[ch];
        if (MODE == 0) dst[(size_t)row * D + 256 + ch] = silu_f(y); else dst[(size_t)row * 256 + ch] = y; }
}
__global__ void k_mixC2(const bf16_t* __restrict__ P, const float* __restrict__ VN  , const float* __restrict__ ws  , const float* __restrict__ bs  , float* __restrict__ YRAW, int r0, int r1) {
    const int idx = blockIdx.x * 256 + threadIdx.x; const int row = r0 + idx / 256, ch = idx % 256;
    if (row >= r1) return;
    int s0, len; row_seq(row, s0, len); const int t = row - s0; const int cb = s0 + (t / 128) * 128, pl = t % 128, h = ch / 64;
    float acc = bs[h * 128 + pl];
    const float* wr = ws + ((size_t)h * 128 + pl) * 128;
    for (int q = 0; q < 128; ++q) acc += wr[q] * VN[(size_t)(cb + q) * 256 + ch];
    YRAW[(size_t)row * D + 512 + ch] = gelu_tanh_f(bf2f(P[(size_t)row * INC + OFF_C + ch])) * acc;
}
__global__ __launch_bounds__(256) void k_attn(const bf16_t* __restrict__ P, const float* __restrict__ rpb  , float* __restrict__ YRAW, int r0, int r1) {
    __shared__ float sc[4][384];
    const int lane = threadIdx.x & 63, w = threadIdx.x >> 6;
    const int item = blockIdx.x * 4 + w; const int row = r0 + item / 4, h = item % 4;
    if (row >= r1) return;
    const bool lat = row < MLAT;
    const int b = lat ? row / SEQ : (row - MLAT) / NCTX;
    const int t = lat ? row % SEQ : 0, gr = t / GRID_W, gc = t % GRID_W;
    const int kr0 = min(max(gr - 4, 0), GROWS - 8), c0 = min(max(gc - 8, 0), GRID_W - 16);
    const int nloc = lat ? 128 : 0, nk = nloc + NCTX;
    const float q = bf2f(P[(size_t)row * INC + OFF_D + h * 64 + lane]) * 0.125f;
    float* s = sc[w];
    for (int i = 0; i < nk; ++i) {
        int krow; float bias = 0.f;
        if (i < nloc) { const int kr = kr0 + i / 16, kc = c0 + i % 16; krow = b * SEQ + kr * GRID_W + kc; bias = rpb[(h * 15 + (kr - gr + 7)) * 31 + (kc - gc + 15)]; }
        else krow = MLAT + b * NCTX + (i - nloc);
        const float d = wave_sum(q * bf2f(P[(size_t)krow * INC + OFF_KV + h * 64 + lane])) + bias;
        if (lane == 0) s[i] = d;
    }
    __syncthreads();
    float m = -1e30f;
    for (int i = lane; i < nk; i += 64) m = fmaxf(m, s[i]);
    m = wave_max(m);
    float sum = 0.f;
    for (int i = lane; i < nk; i += 64) { const float e = __expf(s[i] - m); s[i] = e; sum += e; }
    sum = wave_sum(sum);
    __syncthreads();
    float o = 0.f;
    for (int i = 0; i < nk; ++i) {
        int krow;
        if (i < nloc) { const int kr = kr0 + i / 16, kc = c0 + i % 16; krow = b * SEQ + kr * GRID_W + kc; }
        else krow = MLAT + b * NCTX + (i - nloc);
        o += s[i] * bf2f(P[(size_t)krow * INC + OFF_KV + 256 + h * 64 + lane]);
    }
    YRAW[(size_t)row * D + 768 + h * 64 + lane] = o / sum;
}
__global__ void k_groupnorm(const float* __restrict__ YRAW, const float* __restrict__ gg  , bf16_t* __restrict__ YMIX, int r0, int r1) {
    const int lane = threadIdx.x & 63; const int item = blockIdx.x * 4 + (threadIdx.x >> 6); const int row = r0 + item / 4, g = item % 4;
    if (row >= r1) return;
    const float4 v = *(const float4*)(YRAW + (size_t)row * D + g * 256 + lane * 4);
    const float rstd = rsqrtf(wave_sum(v.x * v.x + v.y * v.y + v.z * v.z + v.w * v.w) * (1.f / 256.f) + EPS);
    const float4 w = *(const float4*)(gg + g * 256 + lane * 4);
    ushort4 o; o.x = f2bf(v.x * rstd * w.x); o.y = f2bf(v.y * rstd * w.y); o.z = f2bf(v.z * rstd * w.z); o.w = f2bf(v.w * rstd * w.w);
    *(ushort4*)(YMIX + (size_t)row * D + g * 256 + lane * 4) = o;
}

#endif

namespace pg8 {
typedef short bf16x8 __attribute__((ext_vector_type(8)));
typedef float f32x4 __attribute__((ext_vector_type(4)));
typedef unsigned u32x4 __attribute__((ext_vector_type(4)));
constexpr int BM = 256, BK = 64, HALF = 128, HTB = HALF * BK * 2  , STAGE_BYTES = 8 * HTB, NXCD = 8, WGM = 8;

__host__ __device__ __forceinline__ int lds_byte(int r, int c) { const int st = (r >> 4) * 2 + (c >> 5), rr = r & 15, cc = c & 31, ob = rr * 64 + cc * 2; return st * 1024 + (ob ^ (((ob >> 9) & 1) << 5)); }
__host__ __device__ __forceinline__ void stage_rc(int b, int& R, int& C) { const int st = b / 1024, sb = b % 1024, swz = sb ^ (((sb >> 9) & 1) << 5); R = (st >> 1) * 16 + swz / 64; C = (st & 1) * 32 + (swz % 64) / 2; }
__host__ __device__ __forceinline__ int perm32(int rho) { const int n = rho >> 4, i = rho & 15; return 8 * (i >> 2) + 4 * n + (i & 3); }

struct Unit { int pm, pn, e, kt0, nkt, slab; };
struct Gemm { const bf16_t* A; const bf16_t* Bt; size_t bstride; int M, N, K; };

struct StaticOrder {
    int nM, nN, nwg, G, c;
    __host__ __device__ void init(int M, int N, int G_, int c_) { nM = M / BM; nN = N / BM; nwg = nM * nN; G = G_; c = c_; }
    __host__ __device__ bool next(int i, Unit& u) const {
        const long L = (long)i * G + c; if (L >= nwg) return false;
        int wgid = (int)L; { const int q = nwg / NXCD, r = nwg % NXCD, xcd = wgid % NXCD, off = wgid / NXCD; wgid = (xcd < r ? xcd * (q + 1) : r * (q + 1) + (xcd - r) * q) + off; }
        const int nig = WGM * nN, gid = wgid / nig, fm = gid * WGM, gsz = (nM - fm) < WGM ? (nM - fm) : WGM;
        u.pm = fm + ((wgid % nig) % gsz); u.pn = (wgid % nig) / gsz; u.e = 0; u.kt0 = 0; u.nkt = 0; u.slab = -1; return true;
    }
};
struct DenseTailOrder {
    StaticOrder so; int nreg_c, ntail, G, c, pm0, S, nkt;
    __device__ void init(int Mreg, int N, int G_, int c_, int ntt, int S_, int nkt_) { so.init(Mreg, N, G_, c_); G = G_; c = c_; pm0 = Mreg / BM; S = S_; nkt = nkt_;
        ntail = ntt * so.nN * S; nreg_c = so.nwg > c ? (so.nwg - c + G - 1) / G : 0; }
    __device__ bool next(int i, Unit& u) const {
        if (i < nreg_c) return so.next(i, u);
        const long q = (long)(i - nreg_c) * G + c; if (q >= ntail) return false;
        u.pm = pm0 + (int)(q / (so.nN * S)); u.pn = (int)((q / S) % so.nN); u.e = 0; u.kt0 = (int)(q % S) * nkt; u.nkt = nkt; u.slab = (int)q; return true;
    }
};
struct OneUnit {
    int pm, pn;
    __device__ bool next(int i, Unit& u) const { if (i != 0) return false; u.pm = pm; u.pn = pn; u.e = 0; u.kt0 = 0; u.nkt = 0; u.slab = -1; return true; }
};
struct GroupedOrder {
    StaticOrder so; int et[9];
    __device__ void init(const int* ebase_rows, int N, int G_, int c_) {
#pragma unroll
        for (int i = 0; i < 9; ++i) et[i] = __builtin_amdgcn_readfirstlane(ebase_rows[i]) / BM;
        so.init(et[8] * BM, N, G_, c_);
    }
    __device__ bool next(int i, Unit& u) const {
        if (!so.next(i, u)) return false;
        int e = 0;
#pragma unroll
        for (int k = 1; k < 8; ++k) e += (u.pm >= et[k]) ? 1 : 0;
        u.e = e; return true;
    }
};

constexpr int SPLITK = 7, SPLIT_NKT = 8;
struct GroupedTailOrder {
    StaticOrder so; int et[9]; int treg, ntail, nreg_c, G, c;
    __device__ void init(const int* ebase_rows, int N, int G_, int c_) {
#pragma unroll
        for (int i = 0; i < 9; ++i) et[i] = __builtin_amdgcn_readfirstlane(ebase_rows[i]) / BM;
        const int nN = N / BM, T = et[8]; G = G_; c = c_;
        const int R = (T * nN) / G; treg = (R * G) / nN; if (treg > T) treg = T; if (T - treg > 8) treg = T;
        ntail = (T - treg) * nN * SPLITK; so.init(treg * BM, N, G_, c_);
        nreg_c = so.nwg > c ? (so.nwg - c + G - 1) / G : 0;
    }
    __device__ bool next(int i, Unit& u) const {
        if (i < nreg_c) { so.next(i, u); }
        else { const long q = (long)(i - nreg_c) * G + c; if (q >= ntail) return false;
            const int nN = so.nN; u.pm = treg + (int)(q / (nN * SPLITK)); u.pn = (int)((q / SPLITK) % nN); u.kt0 = (int)(q % SPLITK) * SPLIT_NKT; u.nkt = SPLIT_NKT; u.slab = (int)q; }
        int e = 0;
#pragma unroll
        for (int k = 1; k < 8; ++k) e += (u.pm >= et[k]) ? 1 : 0;
        u.e = e; return true;
    }
};

typedef float f32x2c __attribute__((ext_vector_type(2))); typedef __bf16 bf16x2c __attribute__((ext_vector_type(2)));
__device__ __forceinline__ unsigned cvt_pk_bf16(float lo, float hi) { const f32x2c v = {lo, hi}; const bf16x2c b = __builtin_convertvector(v, bf16x2c); return __builtin_bit_cast(unsigned, b); }

struct EpiStoreBf16 {
    static constexpr bool PERM = true;
    bf16_t* O; int ldc;
    __device__ __forceinline__ void operator()(const f32x4 (&acc)[2][2][4][2], const Unit& u, int wr, int wc, int fr, int fq) const {
        const int row0 = u.pm * BM + wr * 64 + fr, col0 = u.pn * BM + wc * 32 + 8 * fq;
#pragma unroll
        for (int ai = 0; ai < 2; ++ai)
#pragma unroll
            for (int m = 0; m < 4; ++m) { bf16_t* rowp = O + (size_t)(row0 + ai * HALF + m * 16) * ldc + col0;
#pragma unroll
                for (int bj = 0; bj < 2; ++bj) { const f32x4 v0 = acc[ai][bj][m][0], v1 = acc[ai][bj][m][1];
                    u32x4 w; w.x = cvt_pk_bf16(v0[0], v0[1]); w.y = cvt_pk_bf16(v0[2], v0[3]); w.z = cvt_pk_bf16(v1[0], v1[1]); w.w = cvt_pk_bf16(v1[2], v1[3]);
                    *(u32x4*)(rowp + bj * HALF) = w; } }
    }
};
__device__ __forceinline__ float silu_fast(float x) { return x * __builtin_amdgcn_rcpf(1.f + __builtin_amdgcn_exp2f(-1.4426950408889634f * x)); }
struct EpiSwiglu {
    static constexpr bool PERM = true;
    bf16_t* G; int ldg;
    __device__ __forceinline__ void operator()(const f32x4 (&acc)[2][2][4][2], const Unit& u, int wr, int wc, int fr, int fq) const {
        const int row0 = u.pm * BM + wr * 64 + fr, col0 = u.pn * HALF + wc * 32 + 8 * fq;
#pragma unroll
        for (int ai = 0; ai < 2; ++ai)
#pragma unroll
            for (int m = 0; m < 4; ++m) {
                const f32x4 a0 = acc[ai][0][m][0], a1 = acc[ai][0][m][1], b0 = acc[ai][1][m][0], b1 = acc[ai][1][m][1];
                u32x4 w;
                w.x = cvt_pk_bf16(silu_fast(a0[0]) * b0[0], silu_fast(a0[1]) * b0[1]); w.y = cvt_pk_bf16(silu_fast(a0[2]) * b0[2], silu_fast(a0[3]) * b0[3]);
                w.z = cvt_pk_bf16(silu_fast(a1[0]) * b1[0], silu_fast(a1[1]) * b1[1]); w.w = cvt_pk_bf16(silu_fast(a1[2]) * b1[2], silu_fast(a1[3]) * b1[3]);
                *(u32x4*)(G + (size_t)(row0 + ai * HALF + m * 16) * ldg + col0) = w; }
    }
};
struct EpiResid {
    static constexpr bool PERM = false;
    const float* base_lat; const float* base_ctx; float* out_lat; float* out_ctx; const float* gate; float* slabs;
    __device__ __forceinline__ void operator()(const f32x4 (&acc)[2][2][4][2], const Unit& u, int wr, int wc, int fr, int fq) const {
        if (u.slab >= 0) {
            float* sp = slabs + (size_t)u.slab * (BM * BM) + (size_t)(wr * 64 + fr) * BM + wc * 32 + 4 * fq;
#pragma unroll
            for (int ai = 0; ai < 2; ++ai)
#pragma unroll
                for (int m = 0; m < 4; ++m)
#pragma unroll
                    for (int bj = 0; bj < 2; ++bj)
#pragma unroll
                        for (int n = 0; n < 2; ++n) *(f32x4*)(sp + (size_t)(ai * HALF + m * 16) * BM + bj * HALF + n * 16) = acc[ai][bj][m][n];
            return;
        }
        const bool lat = u.pm < MLAT / BM;
        const int set = lat ? (u.pm >= SEQ / BM ? 1 : 0) : 2 + 0 * u.pm;
        const float* gt = gate + (lat ? set : 2) * MODW;
        const float* bs = lat ? base_lat : base_ctx; float* op = lat ? out_lat : out_ctx;
        const int row0 = (lat ? u.pm * BM : (u.pm - MLAT / BM) * BM) + wr * 64 + fr, col0 = u.pn * BM + wc * 32 + 4 * fq;
        f32x4 gv[2][2];
#pragma unroll
        for (int bj = 0; bj < 2; ++bj)
#pragma unroll
            for (int n = 0; n < 2; ++n) gv[bj][n] = *(const f32x4*)(gt + col0 + bj * HALF + n * 16);
#pragma unroll
        for (int ai = 0; ai < 2; ++ai)
#pragma unroll
            for (int m = 0; m < 4; ++m) { const size_t off = (size_t)(row0 + ai * HALF + m * 16) * D + col0;
#pragma unroll
                for (int bj = 0; bj < 2; ++bj)
#pragma unroll
                    for (int n = 0; n < 2; ++n) { const f32x4 b = *(const f32x4*)(bs + off + bj * HALF + n * 16);
                        *(f32x4*)(op + off + bj * HALF + n * 16) = b + gv[bj][n] * acc[ai][bj][m][n]; } }
    }
};
struct EpiMoeDown {
    static constexpr bool PERM = false;
    float* xl; const int* slot_tok; const float* slot_gate; const float* g2; float* slabs;
    __device__ __forceinline__ void operator()(const f32x4 (&acc)[2][2][4][2], const Unit& u, int wr, int wc, int fr, int fq) const {
        if (u.slab >= 0) {
            float* sp = slabs + (size_t)u.slab * (BM * BM) + (size_t)(wr * 64 + fr) * BM + wc * 32 + 4 * fq;
#pragma unroll
            for (int ai = 0; ai < 2; ++ai)
#pragma unroll
                for (int m = 0; m < 4; ++m)
#pragma unroll
                    for (int bj = 0; bj < 2; ++bj)
#pragma unroll
                        for (int n = 0; n < 2; ++n) *(f32x4*)(sp + (size_t)(ai * HALF + m * 16) * BM + bj * HALF + n * 16) = acc[ai][bj][m][n];
            return;
        }
        const int row0 = u.pm * BM + wr * 64 + fr, col0 = u.pn * BM + wc * 32 + 4 * fq;
#pragma unroll
        for (int ai = 0; ai < 2; ++ai)
#pragma unroll
            for (int m = 0; m < 4; ++m) { const int slot = row0 + ai * HALF + m * 16; const int tok = slot_tok[slot];
                if (tok < 0) continue;
                const float sg = slot_gate[slot]; const float* gt = g2 + (tok >= SEQ ? MODW : 0) + col0; float* xp = xl + (size_t)tok * D + col0;
#pragma unroll
                for (int bj = 0; bj < 2; ++bj)
#pragma unroll
                    for (int n = 0; n < 2; ++n) { const f32x4 gq = *(const f32x4*)(gt + bj * HALF + n * 16); const f32x4 b = *(const f32x4*)(xp + bj * HALF + n * 16);
                        *(f32x4*)(xp + bj * HALF + n * 16) = b + (gq * sg) * acc[ai][bj][m][n]; } }
    }
};

template <class Epi, class Sched, bool GATHER, bool ALIGN_EPI = true>
__device__ __forceinline__ void gemm_phase(LAS unsigned char* lds, const LAS unsigned* gtab, const Gemm g, const Sched& S, const Epi& E, const int tid) {
    const int wid = __builtin_amdgcn_readfirstlane(tid >> 6), lane = tid & 63, wr = wid >> 2, wc = wid & 3, fr = lane & 15, fq = lane >> 4;
    const int K = g.K, ntfull = K / BK;
    const size_t kstep = (size_t)(BK * 2);
    const size_t hstep = (size_t)HALF * K * 2;
    const size_t tstep = 2 * hstep;
    unsigned voffB[2], ga[2][2], gan[2][2]; int RA[2]; unsigned CA2[2];
#pragma unroll
    for (int i = 0; i < 2; ++i) { int R, C; stage_rc(tid * 16 + i * 8192, R, C); const int Rb = Epi::PERM ? ((R & ~31) + perm32(R & 31)) : R;
        voffB[i] = (unsigned)(Rb * K + C) * 2u; RA[i] = R; CA2[i] = (unsigned)C * 2u;
        if (!GATHER) { ga[0][i] = (unsigned)(R * K + C) * 2u; ga[1][i] = ga[0][i] + (unsigned)hstep; gan[0][i] = ga[0][i]; gan[1][i] = ga[1][i]; } }
    const unsigned ldsw = (unsigned)wid * 1024u;
    const int aoff = lds_byte(wr * 64 + fr, fq * 8), boff = lds_byte(wc * 32 + fr, fq * 8);
#define PG8_SA(b, h) (((b) * 2 + (h)) * HTB)
#define PG8_SB(b, h) ((4 + (b) * 2 + (h)) * HTB)
#define PG8_STAGE(bufoff, gbase, voff) do { _Pragma("unroll") for (int _i = 0; _i < 2; ++_i) \
        __builtin_amdgcn_global_load_lds((const unsigned*)((const char*)(gbase) + (voff)[_i]), (LAS unsigned*)(lds + (bufoff) + ldsw + _i * 8192), 16, 0, 0); } while (0)
#define PG8_LDA(dst, b, h) do { _Pragma("unroll") for (int m = 0; m < 4; ++m) _Pragma("unroll") for (int k = 0; k < 2; ++k) dst[m][k] = *(const LAS bf16x8*)(lds + PG8_SA(b, h) + aoff + m * 2048 + k * 1024); } while (0)
#define PG8_LDB(dst, b, h) do { _Pragma("unroll") for (int n = 0; n < 2; ++n) _Pragma("unroll") for (int k = 0; k < 2; ++k) dst[n][k] = *(const LAS bf16x8*)(lds + PG8_SB(b, h) + boff + n * 2048 + k * 1024); } while (0)
#define PG8_MMA(ai, bj, At, Bt) do { __builtin_amdgcn_s_setprio(1); _Pragma("unroll") for (int m = 0; m < 4; ++m) _Pragma("unroll") for (int n = 0; n < 2; ++n) _Pragma("unroll") for (int k = 0; k < 2; ++k) \
        acc[ai][bj][m][n] = __builtin_amdgcn_mfma_f32_16x16x32_bf16(Bt[n][k], At[m][k], acc[ai][bj][m][n], 0, 0, 0); __builtin_amdgcn_s_setprio(0); } while (0)
#define PG8_WAIT_V(n) asm volatile("s_waitcnt vmcnt(" #n ")" ::: "memory")
#define PG8_WAIT_L(n) asm volatile("s_waitcnt lgkmcnt(" #n ")" ::: "memory")
#define PG8_BAR __builtin_amdgcn_s_barrier()
#define PG8_SCHED __builtin_amdgcn_sched_barrier(0)
#define PG8_GLOAD(dst, ui_) do { _Pragma("unroll") for (int _h = 0; _h < 2; ++_h) _Pragma("unroll") for (int _i = 0; _i < 2; ++_i) dst[_h][_i] = gtab[(ui_) * 256 + _h * HALF + RA[_i]] + CA2[_i]; } while (0)
    Unit cur, nxt; int ui = 0;
    if (!S.next(0, cur)) return;
    f32x4 acc[2][2][4][2];
#pragma unroll
    for (int a = 0; a < 2; ++a)
#pragma unroll
        for (int b = 0; b < 2; ++b)
#pragma unroll
            for (int m = 0; m < 4; ++m)
#pragma unroll
                for (int n = 0; n < 2; ++n) acc[a][b][m][n] = (f32x4){0.f, 0.f, 0.f, 0.f};
    bf16x8 At[4][2], B0[2][2], B1[2][2];
    const char* cA = (const char*)g.A + (GATHER ? (size_t)0 : (size_t)cur.pm * tstep) + (size_t)cur.kt0 * kstep;
    const char* cB = (const char*)g.Bt + (size_t)cur.e * g.bstride + (size_t)cur.pn * tstep + (size_t)cur.kt0 * kstep;
    if (GATHER) PG8_GLOAD(ga, 0);
    PG8_STAGE(PG8_SB(0, 0), cB, voffB); PG8_STAGE(PG8_SB(0, 1), cB + hstep, voffB); PG8_STAGE(PG8_SA(0, 0), cA, ga[0]); PG8_STAGE(PG8_SA(0, 1), cA, ga[1]);
    if (wr == 1) PG8_BAR;
    PG8_WAIT_V(2); PG8_BAR;
    PG8_STAGE(PG8_SB(1, 0), cB + kstep, voffB); PG8_STAGE(PG8_SA(1, 0), cA + kstep, ga[0]); PG8_STAGE(PG8_SB(1, 1), cB + hstep + kstep, voffB);
    PG8_WAIT_V(6); PG8_BAR;
    for (;;) {
        const bool has_next = S.next(ui + 1, nxt);
        const char* nA = has_next ? (const char*)g.A + (GATHER ? (size_t)0 : (size_t)nxt.pm * tstep) + (size_t)nxt.kt0 * kstep : cA;
        const char* nB = has_next ? (const char*)g.Bt + (size_t)nxt.e * g.bstride + (size_t)nxt.pn * tstep + (size_t)nxt.kt0 * kstep : cB;
        const int nt = cur.nkt ? cur.nkt : ntfull;
        if (GATHER) { if (has_next) PG8_GLOAD(gan, ui + 1); else { _Pragma("unroll") for (int h = 0; h < 2; ++h) _Pragma("unroll") for (int i = 0; i < 2; ++i) gan[h][i] = ga[h][i]; } }
        for (int t = 0; t < nt; t += 2) {
            const bool last = (t == nt - 2);
            const char* a1 = cA + (size_t)(t + 1) * kstep;
            const char* a2 = last ? nA : cA + (size_t)(t + 2) * kstep; const char* b2 = last ? nB : cB + (size_t)(t + 2) * kstep;
            const char* a3 = a2 + kstep; const char* b3 = b2 + kstep;
            unsigned s2[2][2];
#pragma unroll
            for (int h = 0; h < 2; ++h)
#pragma unroll
                for (int i = 0; i < 2; ++i) s2[h][i] = (GATHER && last) ? gan[h][i] : ga[h][i];
            PG8_LDB(B0, 0, 0); PG8_LDB(B1, 0, 1); PG8_SCHED; PG8_LDA(At, 0, 0); PG8_STAGE(PG8_SA(1, 1), a1, ga[1]);
            PG8_WAIT_V(8); PG8_WAIT_L(0); PG8_BAR; PG8_MMA(0, 0, At, B0); PG8_MMA(0, 1, At, B1); PG8_BAR; PG8_SCHED;
            PG8_LDA(At, 0, 1); PG8_STAGE(PG8_SB(0, 0), b2, voffB); PG8_STAGE(PG8_SB(0, 1), b2 + hstep, voffB); PG8_STAGE(PG8_SA(0, 0), a2, s2[0]);
            PG8_WAIT_V(8); PG8_WAIT_L(0); PG8_BAR; PG8_MMA(1, 0, At, B0); PG8_MMA(1, 1, At, B1); PG8_BAR; PG8_SCHED;
            PG8_LDB(B0, 1, 0); PG8_LDB(B1, 1, 1); PG8_SCHED; PG8_LDA(At, 1, 0); PG8_STAGE(PG8_SA(0, 1), a2, s2[1]);
            PG8_WAIT_V(8); PG8_WAIT_L(0); PG8_BAR; PG8_MMA(0, 0, At, B0); PG8_MMA(0, 1, At, B1); PG8_BAR; PG8_SCHED;
            PG8_LDA(At, 1, 1); PG8_STAGE(PG8_SB(1, 0), b3, voffB); PG8_STAGE(PG8_SB(1, 1), b3 + hstep, voffB); PG8_STAGE(PG8_SA(1, 0), a3, s2[0]);
            PG8_WAIT_V(8); PG8_WAIT_L(0); PG8_BAR; PG8_MMA(1, 0, At, B0); PG8_MMA(1, 1, At, B1); PG8_BAR; PG8_SCHED;
        }
        if (ALIGN_EPI && wr == 0) PG8_BAR;
        E(acc, cur, wr, wc, fr, fq);
        if (!has_next) break;
#pragma unroll
        for (int a = 0; a < 2; ++a)
#pragma unroll
            for (int b = 0; b < 2; ++b)
#pragma unroll
                for (int m = 0; m < 4; ++m)
#pragma unroll
                    for (int n = 0; n < 2; ++n) acc[a][b][m][n] = (f32x4){0.f, 0.f, 0.f, 0.f};
        cur = nxt; cA = nA; cB = nB; ++ui;
#pragma unroll
        for (int h = 0; h < 2; ++h)
#pragma unroll
            for (int i = 0; i < 2; ++i) ga[h][i] = gan[h][i];
        if (ALIGN_EPI && wr == 1) PG8_BAR;
    }
    PG8_WAIT_V(0);
    if (!ALIGN_EPI && wr == 0) PG8_BAR;
    PG8_BAR;
#undef PG8_SA
#undef PG8_SB
#undef PG8_STAGE
#undef PG8_LDA
#undef PG8_LDB
#undef PG8_MMA
#undef PG8_WAIT_V
#undef PG8_WAIT_L
#undef PG8_BAR
#undef PG8_SCHED
#undef PG8_GLOAD
}
}

#define XB_TMO      128
#define XB_XCNT(j)  (256  + 64 * (j))
#define XB_XSUB(j)  (1280 + 64 * (j))
#define XB_XGEN(j)  (2304 + 64 * (j))
#define XB_TOP      3328
#define XB_TOPGEN   3392
#define XCD_BAR_WORDS 3456
#define XB_SPIN_CAP (1u << 18)

__device__ __forceinline__ unsigned xb_ld(unsigned* p)              { return __hip_atomic_load(p, __ATOMIC_RELAXED, __HIP_MEMORY_SCOPE_AGENT); }
__device__ __forceinline__ unsigned xb_add(unsigned* p, unsigned v) { return __hip_atomic_fetch_add(p, v, __ATOMIC_RELAXED, __HIP_MEMORY_SCOPE_AGENT); }
__device__ __forceinline__ unsigned xb_xcc_id() { return (unsigned)__builtin_amdgcn_s_getreg((3 << 11) | 20) & 0xFu; }
#define XB_SPIN(cond, bar) do { unsigned _sp = 0; while (cond) { __builtin_amdgcn_s_sleep(1); \
    if ((++_sp & 255u) == 0u) { if (xb_ld(&(bar)[XB_TMO])) break; if (_sp > XB_SPIN_CAP) { atomicAdd(&(bar)[XB_TMO], 1u); break; } } } } while (0)

struct XcdBarrier {
    unsigned* bar; unsigned x;
    volatile LAS unsigned* st;
};
__device__ __forceinline__ XcdBarrier xcd_barrier_post(unsigned* bar, volatile LAS unsigned* st) {
    XcdBarrier b; b.bar = bar; b.x = xb_xcc_id(); b.st = st;
    if (threadIdx.x == 0) (void)xb_add(&bar[XB_XCNT(b.x)], 1u);
    return b;
}
__device__ __forceinline__ void xcd_barrier_complete(unsigned* bar, unsigned x, unsigned& nloc, unsigned& nx) {
    const unsigned G = gridDim.x * gridDim.y * gridDim.z;
    unsigned sum, cnt, mine, sp = 0u;
    for (;;) {
        sum = 0u; cnt = 0u; mine = 0u;
#pragma unroll
        for (unsigned j = 0; j < 16; ++j) { const unsigned c = xb_ld(&bar[XB_XCNT(j)]); sum += c; cnt += (c > 0u) ? 1u : 0u; mine = (j == x) ? c : mine; }
        if (sum == G) break;
        __builtin_amdgcn_s_sleep(1);
        if ((++sp & 255u) == 0u) { if (xb_ld(&bar[XB_TMO])) break; if (sp > XB_SPIN_CAP) { atomicAdd(&bar[XB_TMO], 1u); break; } }
    }
    nloc = mine > 0u ? mine : 1u; nx = cnt > 0u ? cnt : 1u;
}
__device__ __forceinline__ void xcd_barrier(const XcdBarrier& b) {
    asm volatile("s_waitcnt vmcnt(0)" ::: "memory");
    __syncthreads();
    if (threadIdx.x == 0) {
        unsigned* bar = b.bar;
        __builtin_amdgcn_s_waitcnt(0);
        unsigned nloc = b.st[0], nx = b.st[1];
        if (nloc == 0u) { xcd_barrier_complete(bar, b.x, nloc, nx); b.st[0] = nloc; b.st[1] = nx; }
        const unsigned old = xb_add(&bar[XB_XSUB(b.x)], 1u);
        const unsigned gen = old / nloc;
        if (old + 1u == (gen + 1u) * nloc) {
            __builtin_amdgcn_fence(__ATOMIC_RELEASE, "agent");
            asm volatile("s_waitcnt vmcnt(0)" ::: "memory");
            const unsigned og = xb_add(&bar[XB_TOP], 1u);
            const unsigned tg = og / nx;
            if (og + 1u == (tg + 1u) * nx) xb_add(&bar[XB_TOPGEN], 1u);
            else XB_SPIN(xb_ld(&bar[XB_TOPGEN]) == tg, bar);
            __builtin_amdgcn_fence(__ATOMIC_ACQUIRE, "agent");
            xb_add(&bar[XB_XGEN(b.x)], 1u);
            asm volatile("s_waitcnt vmcnt(0)" ::: "memory");
        } else {
            XB_SPIN(xb_ld(&bar[XB_XGEN(b.x)]) == gen, bar);
            __builtin_amdgcn_fence(__ATOMIC_ACQUIRE, "agent");
            asm volatile("s_waitcnt vmcnt(0)" ::: "memory");
        }
    }
    __syncthreads();
}

typedef float f32x4v __attribute__((ext_vector_type(4)));
typedef unsigned u32x4v __attribute__((ext_vector_type(4)));

__device__ __forceinline__ void tr_item(const float* __restrict__ W, int ldn, int k0, int n0, bf16_t* __restrict__ WT, int ldk, int drow0, LAS float* scr, int lane) {
    float wv[32];
#pragma unroll
    for (int i = 0; i < 32; ++i) { const int kk = 2 * i + (lane >> 5); wv[i] = __builtin_nontemporal_load(W + (size_t)(k0 + kk) * ldn + n0 + (lane & 31)); }
#pragma unroll
    for (int i = 0; i < 32; ++i) { const int kk = 2 * i + (lane >> 5); scr[kk * 33 + (lane & 31)] = wv[i]; }
    asm volatile("s_waitcnt lgkmcnt(0)" ::: "memory");
    const int c = lane & 7;
#pragma unroll
    for (int j = 0; j < 4; ++j) { const int n = (lane >> 3) + 8 * j; const LAS float* s = scr + (8 * c) * 33 + n;
        u32x4v o; o.x = pk2(s[0 * 33], s[1 * 33]); o.y = pk2(s[2 * 33], s[3 * 33]); o.z = pk2(s[4 * 33], s[5 * 33]); o.w = pk2(s[6 * 33], s[7 * 33]);
        __builtin_nontemporal_store(o, (u32x4v*)(WT + (size_t)(drow0 + n) * ldk + k0 + 8 * c)); }
    asm volatile("s_waitcnt lgkmcnt(0)" ::: "memory");
}
struct KArgs {
    const float* in[30]; float* out; unsigned char* ws;
    int ph_lo, ph_hi, li, flags;
};
enum { IN_X = 0, IN_C, IN_CTX, IN_CCTX, IN_WMOD, IN_BMOD, IN_N1G, IN_N2G, IN_WIN, IN_CAW, IN_CBW, IN_CBB, IN_CLG, IN_CLB, IN_SLG, IN_SLB, IN_SGW, IN_SGB, IN_RPB, IN_GG, IN_WOUT,
       IN_FW1, IN_FW3, IN_FW2, IN_RW, IN_RB, IN_MW1, IN_MW3, IN_MW2, IN_FG };
enum { PH_PRO = 0, PH_N1_0, PH_G1_0, PH_MIX_0, PH_G2_0, PH_N2_0, PH_F1_0, PH_F2_0, PH_N1_1, PH_G1_1, PH_MIX_1, PH_MOECONV, PH_G2_1, PH_RT, PH_PLAN, PH_M1A, PH_M2A, PH_M1B, PH_M2B, PH_FIN, PH_COUNT };

constexpr int IT_WIN = 2 * 16 * 80, IT_WOUT = 2 * 16 * 32, IT_F1 = 16 * 88, IT_F2 = 44 * 32, IT_DENSE = IT_WIN + IT_WOUT + 2 * IT_F1 + IT_F2;
constexpr int IT_M1 = 16 * 112, IT_M2 = 56 * 32, IT_ME = 2 * IT_M1 + IT_M2, IT_MOE = NEXP * IT_ME;
__device__ __forceinline__ void conv_item(const KArgs& a, unsigned char* ws, int it, LAS float* scr, int lane) {
    if (it < IT_WIN) { const int l = it / 1280, r = it % 1280, kb = r / 80, nb = r % 80;
        tr_item(a.in[IN_WIN] + (size_t)l * D * INC, INC, kb * 64, nb * 32, (bf16_t*)(ws + WS_WIN) + (size_t)l * INC * D, D, nb * 32, scr, lane); return; }
    it -= IT_WIN;
    if (it < IT_WOUT) { const int l = it / 512, r = it % 512, kb = r / 32, nb = r % 32;
        tr_item(a.in[IN_WOUT] + (size_t)l * D * D, D, kb * 64, nb * 32, (bf16_t*)(ws + WS_WOUT) + (size_t)l * D * D, D, nb * 32, scr, lane); return; }
    it -= IT_WOUT;
    if (it < 2 * IT_F1) { const int w3 = it / IT_F1, r = it % IT_F1, kb = r / 88, nb = r % 88, n0 = nb * 32;
        tr_item((w3 ? a.in[IN_FW3] : a.in[IN_FW1]), DFF, kb * 64, n0, (bf16_t*)(ws + WS_W13), D, (n0 / 128) * 256 + (n0 % 128) + w3 * 128, scr, lane); return; }
    it -= 2 * IT_F1;
    if (it < IT_F2) { const int kb = it / 32, nb = it % 32;
        tr_item(a.in[IN_FW2], D, kb * 64, nb * 32, (bf16_t*)(ws + WS_W2), DFF, nb * 32, scr, lane); return; }
    it -= IT_F2;
    const int e = it / IT_ME; int r = it % IT_ME;
    if (r < 2 * IT_M1) { const int w3 = r / IT_M1; r %= IT_M1; const int kb = r / 112, nb = r % 112, n0 = nb * 32;
        tr_item((w3 ? a.in[IN_MW3] : a.in[IN_MW1]) + (size_t)e * D * DFE, DFE, kb * 64, n0, (bf16_t*)(ws + WS_MW13) + (size_t)e * 2 * DFE * D, D, (n0 / 128) * 256 + (n0 % 128) + w3 * 128, scr, lane); return; }
    r -= 2 * IT_M1;
    { const int kb = r / 32, nb = r % 32;
      tr_item(a.in[IN_MW2] + (size_t)e * DFE * D, D, kb * 64, nb * 32, (bf16_t*)(ws + WS_MW2) + (size_t)e * D * DFE, DFE, nb * 32, scr, lane); }
}
__device__ __forceinline__ void ph_convert(const KArgs& a, unsigned char* ws, LAS unsigned char* lds, int it_lo, int it_hi, int gw, int ngw, int wave, int lane) {
    LAS float* scr = (LAS float*)(lds + wave * 16384);
    for (int it = it_lo + gw; it < it_hi; it += ngw) conv_item(a, ws, it, scr, lane);
}
__device__ __forceinline__ void ph_mod(const KArgs& a, unsigned char* ws, LAS unsigned char* lds, int blk, int nblk, int tid, int wave, int lane) {
    __syncthreads();
    LAS float* sil = (LAS float*)lds;
    LAS float* red = sil + 3 * D;
    for (int i = tid; i < 3 * D; i += NTHR) { const int s = i / D, k = i % D; sil[i] = silu_f(s < 2 ? a.in[IN_C][s * D + k] : a.in[IN_CCTX][k]); }
    __syncthreads();
    float* mod = (float*)(ws + WS_MOD);
    for (int item = blk; item < 2 * (MODW / 64); item += nblk) {
        const int l = item / (MODW / 64), j0 = (item % (MODW / 64)) * 64;
        const float* w = a.in[IN_WMOD] + ((size_t)l * D + wave * 128) * MODW + j0 + lane;
        float a0 = 0.f, a1 = 0.f, a2 = 0.f;
#pragma unroll 8
        for (int kk = 0; kk < 128; ++kk) { const float wv = w[(size_t)kk * MODW]; const int k = wave * 128 + kk; a0 += sil[k] * wv; a1 += sil[D + k] * wv; a2 += sil[2 * D + k] * wv; }
        red[(wave * 3 + 0) * 64 + lane] = a0; red[(wave * 3 + 1) * 64 + lane] = a1; red[(wave * 3 + 2) * 64 + lane] = a2;
        __syncthreads();
        if (tid < 192) { const int s = tid / 64, j = tid % 64; float v = a.in[IN_BMOD][l * MODW + j0 + j];
#pragma unroll
            for (int w8 = 0; w8 < 8; ++w8) v += red[(w8 * 3 + s) * 64 + j];
            mod[(l * 3 + s) * MODW + j0 + j] = v; }
        __syncthreads();
    }
}
#define DPP_ADD(v, ctrl) (v) += __builtin_bit_cast(float, __builtin_amdgcn_mov_dpp(__builtin_bit_cast(int, (v)), (ctrl), 0xf, 0xf, true))
__device__ __forceinline__ float wave_sum_fast(float v) {
    DPP_ADD(v, 0xB1); DPP_ADD(v, 0x4E); DPP_ADD(v, 0x141); DPP_ADD(v, 0x140);
    const int iv = __builtin_bit_cast(int, v);
    const float r0 = __builtin_bit_cast(float, __builtin_amdgcn_readlane(iv, 0)), r1 = __builtin_bit_cast(float, __builtin_amdgcn_readlane(iv, 16));
    const float r2 = __builtin_bit_cast(float, __builtin_amdgcn_readlane(iv, 32)), r3 = __builtin_bit_cast(float, __builtin_amdgcn_readlane(iv, 48));
    return (r0 + r1) + (r2 + r3);
}
constexpr int F2_SPLITK = 11, F2_NKT = 4;
__device__ __forceinline__ void ph_norm(const float* __restrict__ xlat, const float* __restrict__ xctx, const float* __restrict__ g, const float* __restrict__ modl, int cshift, int cscale,
                                        bf16_t* __restrict__ H, int r1, int gw, int ngw, int lane, const float* __restrict__ slabs = nullptr, const float* __restrict__ sgate = nullptr) {
    f32x4v nx[4];
    if (gw < r1) { const float* src = gw < MLAT ? xlat + (size_t)gw * D : xctx + (size_t)(gw - MLAT) * D;
#pragma unroll
        for (int j = 0; j < 4; ++j) nx[j] = *(const f32x4v*)(src + (lane + 64 * j) * 4); }
    for (int row = gw; row < r1; row += ngw) {
        const float* md = modl + row_modset(row) * MODW;
        f32x4v v[4]; float ss = 0.f;
#pragma unroll
        for (int j = 0; j < 4; ++j) { v[j] = nx[j]; ss += (v[j].x * v[j].x + v[j].y * v[j].y) + (v[j].z * v[j].z + v[j].w * v[j].w); }
        const int rn = row + ngw;
        if (rn < r1) { const float* src = rn < MLAT ? xlat + (size_t)rn * D : xctx + (size_t)(rn - MLAT) * D;
#pragma unroll
            for (int j = 0; j < 4; ++j) nx[j] = *(const f32x4v*)(src + (lane + 64 * j) * 4); }
        if (slabs && row >= MLAT) {
            const int tile = (row - MLAT) >> 8, r = (row - MLAT) & 255; ss = 0.f;
#pragma unroll
            for (int j = 0; j < 4; ++j) { const int col = (lane + 64 * j) * 4; f32x4v s4 = (f32x4v){0.f, 0.f, 0.f, 0.f};
                for (int s = 0; s < F2_SPLITK; ++s) s4 += *(const f32x4v*)(slabs + ((size_t)((tile * 4 + j) * F2_SPLITK + s) * 256 + r) * 256 + (col & 255));
                v[j] += s4 * *(const f32x4v*)(sgate + col); ss += (v[j].x * v[j].x + v[j].y * v[j].y) + (v[j].z * v[j].z + v[j].w * v[j].w); } }
        const float rstd = rsqrtf(wave_sum_fast(ss) * (1.f / D) + EPS);
#pragma unroll
        for (int j = 0; j < 4; ++j) {
            const int col = (lane + 64 * j) * 4;
            const f32x4v gg = *(const f32x4v*)(g + col), sc = *(const f32x4v*)(md + cscale * D + col), sh = *(const f32x4v*)(md + cshift * D + col);
            const f32x4v hv = v[j] * rstd * gg * (1.f + sc) + sh;
            uint2 o; o.x = pk2(hv.x, hv.y); o.y = pk2(hv.z, hv.w);
            *(uint2*)(H + (size_t)row * D + col) = o;
        }
    }
}
__device__ __forceinline__ void ph_route(const KArgs& a, unsigned char* ws, LAS unsigned char* lds, const float* __restrict__ xl, const float* __restrict__ g, const float* __restrict__ modl, int blk, int tid, int wave, int lane) {
    LAS int* se = (LAS int*)lds;
    LAS float* sg = (LAS float*)(lds + 1024);
    bf16_t* H = (bf16_t*)(ws + WS_H);
    const float* rw = a.in[IN_RW]; const float* rb = a.in[IN_RB];
    const float* md = modl + row_modset(blk * 128) * MODW;
    f32x4v wA[4], wB[4]; float wr[16][8];
#pragma unroll
    for (int j = 0; j < 4; ++j) { const int col = (lane + 64 * j) * 4;
        wA[j] = *(const f32x4v*)(g + col) * (1.f + *(const f32x4v*)(md + 4 * D + col)); wB[j] = *(const f32x4v*)(md + 3 * D + col);
#pragma unroll
        for (int q = 0; q < 4; ++q) { const f32x4v w0 = *(const f32x4v*)(rw + (size_t)(col + q) * NEXP), w1 = *(const f32x4v*)(rw + (size_t)(col + q) * NEXP + 4);
            wr[j * 4 + q][0] = w0.x; wr[j * 4 + q][1] = w0.y; wr[j * 4 + q][2] = w0.z; wr[j * 4 + q][3] = w0.w; wr[j * 4 + q][4] = w1.x; wr[j * 4 + q][5] = w1.y; wr[j * 4 + q][6] = w1.z; wr[j * 4 + q][7] = w1.w; } }
    float rbv[NEXP];
#pragma unroll
    for (int e = 0; e < NEXP; ++e) rbv[e] = rb[e];
    const int row0 = blk * 128 + wave * 16;
    f32x4v nx[4], ny[4];
#pragma unroll
    for (int j = 0; j < 4; ++j) { nx[j] = *(const f32x4v*)(xl + (size_t)row0 * D + (lane + 64 * j) * 4); ny[j] = *(const f32x4v*)(xl + (size_t)(row0 + 1) * D + (lane + 64 * j) * 4); }
    for (int i = 0; i < 16; ++i) {
        const int tl = wave * 16 + i, row = row0 + i;
        f32x4v v[4]; float ss = 0.f;
#pragma unroll
        for (int j = 0; j < 4; ++j) { v[j] = nx[j]; nx[j] = ny[j]; ss += (v[j].x * v[j].x + v[j].y * v[j].y) + (v[j].z * v[j].z + v[j].w * v[j].w); }
        if (i + 2 < 16) {
#pragma unroll
            for (int j = 0; j < 4; ++j) ny[j] = *(const f32x4v*)(xl + (size_t)(row + 2) * D + (lane + 64 * j) * 4);
        }
        const float rstd = rsqrtf(wave_sum_fast(ss) * (1.f / D) + EPS);
        float lg[NEXP] = {0.f, 0.f, 0.f, 0.f, 0.f, 0.f, 0.f, 0.f};
#pragma unroll
        for (int j = 0; j < 4; ++j) {
            const int col = (lane + 64 * j) * 4;
            const f32x4v hv = v[j] * rstd * wA[j] + wB[j];
            uint2 o; o.x = pk2(hv.x, hv.y); o.y = pk2(hv.z, hv.w);
            *(uint2*)(H + (size_t)row * D + col) = o;
#pragma unroll
            for (int q = 0; q < 4; ++q) {
                const float hq = hv[q];
#pragma unroll
                for (int e = 0; e < NEXP; ++e) lg[e] += hq * wr[j * 4 + q][e];
            }
        }
#pragma unroll
        for (int e = 0; e < NEXP; ++e) lg[e] = wave_sum_fast(lg[e]) + rbv[e];
        int e0 = 0; float v0 = lg[0];
#pragma unroll
        for (int e = 1; e < NEXP; ++e) if (lg[e] > v0) { v0 = lg[e]; e0 = e; }
        int e1 = -1; float v1 = -3.4e38f;
#pragma unroll
        for (int e = 0; e < NEXP; ++e) if (e != e0 && lg[e] > v1) { v1 = lg[e]; e1 = e; }
        const float p1 = __expf(v1 - v0), inv = 1.f / (1.f + p1);
        if (lane == 0) { se[tl] = e0; se[128 + tl] = e1; sg[tl] = inv; sg[128 + tl] = p1 * inv; }
    }
#pragma unroll
    for (int j = 0; j < 4; ++j) asm volatile("" :: "v"(nx[j]), "v"(ny[j]));
    __syncthreads();
    int* sel_e = (int*)(ws + WS_SEL + SEL_E); float* sel_g = (float*)(ws + WS_SEL + SEL_G); int* sel_r = (int*)(ws + WS_SEL + SEL_R);
    int* slot_tok = (int*)(ws + WS_SLOT + SLOT_TOK); int* hist = (int*)(ws + WS_SLOT + SLOT_HIST);
    if (tid < 256) { const int k = tid >> 7, tl = tid & 127, e = se[k * 128 + tl]; int r = 0;
        for (int t2 = 0; t2 < tl; ++t2) r += (se[k * 128 + t2] == e) ? 1 : 0;
        const int t = blk * 128 + tl; sel_e[t * 2 + k] = e; sel_g[t * 2 + k] = sg[k * 128 + tl]; sel_r[t * 2 + k] = r; }
    else if (tid < 256 + 16) { const int j = tid - 256, k = j >> 3, e = j & 7; int c = 0;
        for (int t2 = 0; t2 < 128; ++t2) c += (se[k * 128 + t2] == e) ? 1 : 0;
        hist[blk * 16 + j] = c; }
    for (int i = blk * NTHR + tid; i < 2 * PASS_ROWS; i += NBLK * NTHR) slot_tok[i] = -1;
    __syncthreads();
}
__device__ __forceinline__ void ph_plan(unsigned char* ws, LAS unsigned char* lds, int blk, int tid) {
    LAS int* tot = (LAS int*)lds; LAS int* pre = tot + 16; LAS int* eb = tot + 32;
    const int* hist = (const int*)(ws + WS_SLOT + SLOT_HIST);
    LAS int* hl = (LAS int*)(lds + GTAB_OFF);
    for (int i = tid; i < NBLK * 16; i += NTHR) hl[i] = hist[i];
    __syncthreads();
    if (tid < 16) { int t = 0, p = 0; for (int bb = 0; bb < NBLK; ++bb) { const int v = hl[bb * 16 + tid]; t += v; p += (bb < blk) ? v : 0; } tot[tid] = t; pre[tid] = p; }
    __syncthreads();
    if (tid == 0) { int* ebg = (int*)(ws + WS_SLOT + SLOT_EBASE);
        for (int k = 0; k < 2; ++k) { int base = 0; for (int e = 0; e <= NEXP; ++e) { eb[k * 9 + e] = base; if (blk == 0) ebg[k * 9 + e] = base; if (e < NEXP) base += (tot[k * 8 + e] + 255) / 256 * 256; } } }
    __syncthreads();
    const int* sel_e = (const int*)(ws + WS_SEL + SEL_E); const float* sel_g = (const float*)(ws + WS_SEL + SEL_G); const int* sel_r = (const int*)(ws + WS_SEL + SEL_R);
    int* slot_tok = (int*)(ws + WS_SLOT + SLOT_TOK); float* slot_gate = (float*)(ws + WS_SLOT + SLOT_GATE);
    if (tid < 256) { const int k = tid >> 7, t = blk * 128 + (tid & 127), e = sel_e[t * 2 + k];
        const int ps = eb[k * 9 + e] + pre[k * 8 + e] + sel_r[t * 2 + k], slot = k * PASS_ROWS + ps; slot_tok[slot] = t; slot_gate[slot] = sel_g[t * 2 + k]; ((int*)(ws + WS_SEL + SEL_S))[t * 2 + k] = ps; }
    __syncthreads();
}
__device__ __forceinline__ void ph_final(float* __restrict__ xl, const float* __restrict__ fg, unsigned char* ws, const float* __restrict__ g2l  , int gw, int ngw, int lane) {
    const int* ebase = (const int*)(ws + WS_SLOT + SLOT_EBASE); const int* sel_s = (const int*)(ws + WS_SEL + SEL_S); const float* sel_g = (const float*)(ws + WS_SEL + SEL_G);
    int tail0[2];
#pragma unroll
    for (int k = 0; k < 2; ++k) { const int T = ebase[k * 9 + 8] / 256, R = (T * 4) / NBLK; int treg = (R * NBLK) / 4; if (treg > T) treg = T; if (T - treg > 8) treg = T; tail0[k] = treg * 256; }
    f32x4v nx[4];
    if (gw < MLAT) {
#pragma unroll
        for (int j = 0; j < 4; ++j) nx[j] = *(const f32x4v*)(xl + (size_t)gw * D + (lane + 64 * j) * 4); }
    for (int row = gw; row < MLAT; row += ngw) {
        float* p = xl + (size_t)row * D; f32x4v v[4];
#pragma unroll
        for (int j = 0; j < 4; ++j) v[j] = nx[j];
        if (row + ngw < MLAT) {
#pragma unroll
            for (int j = 0; j < 4; ++j) nx[j] = *(const f32x4v*)(xl + (size_t)(row + ngw) * D + (lane + 64 * j) * 4); }
#pragma unroll
        for (int k = 0; k < 2; ++k) { const int ps = sel_s[row * 2 + k];
            if (ps >= tail0[k]) {
                const int tt = (ps - tail0[k]) >> 8, r = (ps - tail0[k]) & 255; const float sg = sel_g[row * 2 + k];
                const float* slabs = (const float*)(ws + (k == 0 ? WS_SLAB0 : WS_H)); const float* gt = g2l + (row >= SEQ ? MODW : 0);
#pragma unroll
                for (int j = 0; j < 4; ++j) { const int col = (lane + 64 * j) * 4; f32x4v s4 = (f32x4v){0.f, 0.f, 0.f, 0.f};
                    for (int s = 0; s < pg8::SPLITK; ++s) s4 += *(const f32x4v*)(slabs + ((size_t)((tt * 4 + j) * pg8::SPLITK + s) * 256 + r) * 256 + (col & 255));
                    v[j] += s4 * sg * *(const f32x4v*)(gt + col); } } }
        float ss = 0.f;
#pragma unroll
        for (int j = 0; j < 4; ++j) ss += (v[j].x * v[j].x + v[j].y * v[j].y) + (v[j].z * v[j].z + v[j].w * v[j].w);
        const float rstd = rsqrtf(wave_sum_fast(ss) * (1.f / D) + EPS);
#pragma unroll
        for (int j = 0; j < 4; ++j) { const int col = (lane + 64 * j) * 4; *(f32x4v*)(p + col) = v[j] * rstd * *(const f32x4v*)(fg + col); }
    }
}

__device__ __forceinline__ void nv_mixA(const bf16_t* __restrict__ P, const float* __restrict__ wA, float* __restrict__ YRAW, int r1, int vb0, int nvb, int ch) {
    for (int row = vb0; row < r1; row += nvb) {
        int s0, len; row_seq(row, s0, len); const int t = row - s0;
        float acc = 0.f;
        for (int j = 0; j < 3; ++j) { const int tt = t + j - 1; if (tt < 0 || tt >= len) continue;
            const bf16_t* pr = P + (size_t)(s0 + tt) * INC + OFF_A; acc += wA[j * 256 + ch] * (bf2f(pr[256 + ch]) * bf2f(pr[512 + ch])); }
        YRAW[(size_t)row * D + ch] = bf2f(P[(size_t)row * INC + OFF_A + ch]) * acc;
    }
}
__device__ __forceinline__ void nv_mixB1(const bf16_t* __restrict__ P, const float* __restrict__ wB, const float* __restrict__ bB, float* __restrict__ TMP, int r1, int vb0, int nvb, int ch) {
    for (int row = vb0; row < r1; row += nvb) {
        int s0, len; row_seq(row, s0, len); const int t = row - s0;
        float acc = bB[ch];
        for (int j = 0; j < 31; ++j) { const int tt = t + j - 15; if (tt < 0 || tt >= len) continue;
            const bf16_t* pr = P + (size_t)(s0 + tt) * INC + OFF_B; acc += wB[j * 256 + ch] * (bf2f(pr[ch]) * sigmoid_f(bf2f(pr[256 + ch]))); }
        TMP[(size_t)row * 256 + ch] = acc;
    }
}
template <int MODE> __device__ __forceinline__ void nv_ln256(const float* __restrict__ TMPin, const bf16_t* __restrict__ P, const float* __restrict__ g, const float* __restrict__ b, float* __restrict__ dst, int r1, int gw, int ngw, int lane) {
    for (int row = gw; row < r1; row += ngw) {
        float v[4];
#pragma unroll
        for (int i = 0; i < 4; ++i) { const int ch = lane * 4 + i; v[i] = MODE == 0 ? TMPin[(size_t)row * 256 + ch] : gelu_tanh_f(bf2f(P[(size_t)row * INC + OFF_C + 256 + ch])); }
        const float mu = wave_sum(v[0] + v[1] + v[2] + v[3]) * (1.f / 256.f);
        float q = 0.f;
#pragma unroll
        for (int i = 0; i < 4; ++i) { v[i] -= mu; q += v[i] * v[i]; }
        const float rstd = rsqrtf(wave_sum(q) * (1.f / 256.f) + EPS);
#pragma unroll
        for (int i = 0; i < 4; ++i) { const int ch = lane * 4 + i; const float y = v[i] * rstd * g[ch] + b[ch];
            if (MODE == 0) dst[(size_t)row * D + 256 + ch] = silu_f(y); else dst[(size_t)row * 256 + ch] = y; }
    }
}
__device__ __forceinline__ void nv_mixC2(const bf16_t* __restrict__ P, const float* __restrict__ VN, const float* __restrict__ wsg, const float* __restrict__ bs, float* __restrict__ YRAW, int r1, int vb0, int nvb, int ch) {
    for (int row = vb0; row < r1; row += nvb) {
        int s0, len; row_seq(row, s0, len); const int t = row - s0; const int cb = s0 + (t / 128) * 128, pl = t % 128, h = ch / 64;
        float acc = bs[h * 128 + pl];
        const float* wr = wsg + ((size_t)h * 128 + pl) * 128;
        for (int q = 0; q < 128; ++q) acc += wr[q] * VN[(size_t)(cb + q) * 256 + ch];
        YRAW[(size_t)row * D + 512 + ch] = gelu_tanh_f(bf2f(P[(size_t)row * INC + OFF_C + ch])) * acc;
    }
}
__device__ __forceinline__ void nv_attn(const bf16_t* __restrict__ P, const float* __restrict__ rpb, float* __restrict__ YRAW, int r1, int gw, int ngw, int lane, LAS float* s) {
    for (int item = gw; item < r1 * 4; item += ngw) {
        const int row = item >> 2, h = item & 3;
        const bool lat = row < MLAT;
        const int b = lat ? row / SEQ : (row - MLAT) / NCTX;
        const int t = lat ? row % SEQ : 0, gr = t / GRID_W, gc = t % GRID_W;
        const int kr0 = min(max(gr - 4, 0), GROWS - 8), c0 = min(max(gc - 8, 0), GRID_W - 16);
        const int nloc = lat ? 128 : 0, nk = nloc + NCTX;
        const float q = bf2f(P[(size_t)row * INC + OFF_D + h * 64 + lane]) * 0.125f;
        for (int i = 0; i < nk; ++i) {
            int krow; float bias = 0.f;
            if (i < nloc) { const int kr = kr0 + i / 16, kc = c0 + i % 16; krow = b * SEQ + kr * GRID_W + kc; bias = rpb[(h * 15 + (kr - gr + 7)) * 31 + (kc - gc + 15)]; }
            else krow = MLAT + b * NCTX + (i - nloc);
            const float d = wave_sum(q * bf2f(P[(size_t)krow * INC + OFF_KV + h * 64 + lane])) + bias;
            if (lane == 0) s[i] = d;
        }
        asm volatile("s_waitcnt lgkmcnt(0)" ::: "memory");
        float m = -1e30f;
        for (int i = lane; i < nk; i += 64) m = fmaxf(m, s[i]);
        m = wave_max(m);
        float sum = 0.f;
        for (int i = lane; i < nk; i += 64) { const float e = __expf(s[i] - m); s[i] = e; sum += e; }
        sum = wave_sum(sum);
        asm volatile("s_waitcnt lgkmcnt(0)" ::: "memory");
        float o = 0.f;
        for (int i = 0; i < nk; ++i) {
            int krow;
            if (i < nloc) { const int kr = kr0 + i / 16, kc = c0 + i % 16; krow = b * SEQ + kr * GRID_W + kc; }
            else krow = MLAT + b * NCTX + (i - nloc);
            o += s[i] * bf2f(P[(size_t)krow * INC + OFF_KV + 256 + h * 64 + lane]);
        }
        YRAW[(size_t)row * D + 768 + h * 64 + lane] = o / sum;
        asm volatile("s_waitcnt lgkmcnt(0)" ::: "memory");
    }
}
__device__ __forceinline__ void nv_groupnorm(const float* __restrict__ YRAW, const float* __restrict__ gg, bf16_t* __restrict__ YMIX, int r1, int gw, int ngw, int lane) {
    for (int item = gw; item < r1 * 4; item += ngw) {
        const int row = item >> 2, g = item & 3;
        const f32x4v v = *(const f32x4v*)(YRAW + (size_t)row * D + g * 256 + lane * 4);
        const float rstd = rsqrtf(wave_sum((v.x * v.x + v.y * v.y) + (v.z * v.z + v.w * v.w)) * (1.f / 256.f) + EPS);
        const f32x4v w = *(const f32x4v*)(gg + g * 256 + lane * 4);
        uint2 o; o.x = pk2(v.x * rstd * w.x, v.y * rstd * w.y); o.y = pk2(v.z * rstd * w.z, v.w * rstd * w.w);
        *(uint2*)(YMIX + (size_t)row * D + g * 256 + lane * 4) = o;
    }
}

#ifndef MX_A
#define MX_A 1
#endif
#ifndef MX_B
#define MX_B 1
#endif
#ifndef MX_C
#define MX_C 1
#endif
#ifndef MX_D
#define MX_D 1
#endif
namespace mx {
typedef short bf16x8 __attribute__((ext_vector_type(8)));
typedef short s16x4 __attribute__((ext_vector_type(4)));
typedef float f32x4 __attribute__((ext_vector_type(4)));
typedef float f32x16 __attribute__((ext_vector_type(16)));
typedef unsigned u32x4 __attribute__((ext_vector_type(4)));
constexpr float LOG2E = 1.4426950408889634f;
__device__ __forceinline__ float gelu_fast(float x) {
    const float u = 0.7978845608028654f * (x + 0.044715f * x * x * x);
    return x * __builtin_amdgcn_rcpf(1.f + __builtin_amdgcn_exp2f(-2.f * LOG2E * u));
}
__device__ __forceinline__ float sigmoid_fast(float x) { return __builtin_amdgcn_rcpf(1.f + __builtin_amdgcn_exp2f(-LOG2E * x)); }
__device__ __forceinline__ f32x4 ld_bf4(const bf16_t* p) { const uint2 v = *(const uint2*)p; return (f32x4){__uint_as_float(v.x << 16), __uint_as_float(v.x & 0xffff0000u), __uint_as_float(v.y << 16), __uint_as_float(v.y & 0xffff0000u)}; }
__device__ __forceinline__ void st_bf4(bf16_t* p, f32x4 v);
typedef float f32x2_t __attribute__((ext_vector_type(2))); typedef __bf16 bf16x2_t __attribute__((ext_vector_type(2)));
__device__ __forceinline__ unsigned cvtpk(float lo, float hi) { const f32x2_t v = {lo, hi}; const bf16x2_t b = __builtin_convertvector(v, bf16x2_t); return __builtin_bit_cast(unsigned, b); }
__device__ __forceinline__ float sum4(f32x4 v) { return (v.x + v.y) + (v.z + v.w); }
__device__ __forceinline__ void st_bf4(bf16_t* p, f32x4 v) { uint2 o; o.x = cvtpk(v.x, v.y); o.y = cvtpk(v.z, v.w); *(uint2*)p = o; }

__device__ __forceinline__ void item_A(const bf16_t* __restrict__ P, const float* __restrict__ wA  , const float* __restrict__ gg  , bf16_t* __restrict__ YMIX, int r0, int wave, int lane) {
    int s0, len; row_seq(r0, s0, len);
    const int ch = lane * 4, t0 = r0 - s0 + wave * 16;
    const f32x4 w0 = *(const f32x4*)(wA + ch), w1 = *(const f32x4*)(wA + 256 + ch), w2 = *(const f32x4*)(wA + 512 + ch), g = *(const f32x4*)(gg + ch);
    f32x4 u[18];
#pragma unroll
    for (int i = 0; i < 18; ++i) { const int tt = t0 + i - 1;
        if (tt >= 0 && tt < len) { const bf16_t* pr = P + (size_t)(s0 + tt) * INC + OFF_A + ch; u[i] = ld_bf4(pr + 256) * ld_bf4(pr + 512); } else u[i] = (f32x4){0.f, 0.f, 0.f, 0.f}; }
#pragma unroll
    for (int i = 0; i < 16; ++i) { const size_t row = (size_t)(s0 + t0 + i);
        const f32x4 y = ld_bf4(P + row * INC + OFF_A + ch) * (w0 * u[i] + w1 * u[i + 1] + w2 * u[i + 2]);
        const float rstd = rsqrtf(wave_sum_fast(sum4(y * y)) * (1.f / 256.f) + EPS);
        st_bf4(YMIX + row * D + ch, y * rstd * g); }
}

__device__ __forceinline__ void item_B(const bf16_t* __restrict__ P, const float* __restrict__ wB  , const float* __restrict__ bB, const float* __restrict__ lg, const float* __restrict__ lb,
                                       const float* __restrict__ gg  , bf16_t* __restrict__ YMIX, LAS unsigned char* lds, int r0, int wave, int lane) {
    int s0, len; row_seq(r0, s0, len);
    const int ch = lane * 4;
    LAS float* tile = (LAS float*)lds;
    f32x4 w[31];
#pragma unroll
    for (int j = 0; j < 31; ++j) w[j] = *(const f32x4*)(wB + j * 256 + ch);
    const f32x4 bias = *(const f32x4*)(bB + ch), g1 = *(const f32x4*)(lg + ch), b1 = *(const f32x4*)(lb + ch), g2 = *(const f32x4*)(gg + ch);
    for (int sub = 0; sub < 2; ++sub) {
        const int t0 = r0 - s0 + sub * 64;
        { uint2 ra[12], rg[12];
#pragma unroll
          for (int i = 0; i < 12; ++i) { const int rr = wave + 8 * i, tt = t0 - 15 + rr; ra[i] = make_uint2(0u, 0u); rg[i] = make_uint2(0u, 0u);
              if (rr < 94 && tt >= 0 && tt < len) { const bf16_t* pr = P + (size_t)(s0 + tt) * INC + OFF_B + ch; ra[i] = *(const uint2*)pr; rg[i] = *(const uint2*)(pr + 256); } }
#pragma unroll
          for (int i = 0; i < 12; ++i) { const int rr = wave + 8 * i;
              if (rr < 94) { const f32x4 a = (f32x4){__uint_as_float(ra[i].x << 16), __uint_as_float(ra[i].x & 0xffff0000u), __uint_as_float(ra[i].y << 16), __uint_as_float(ra[i].y & 0xffff0000u)};
                  const f32x4 gt = (f32x4){__uint_as_float(rg[i].x << 16), __uint_as_float(rg[i].x & 0xffff0000u), __uint_as_float(rg[i].y << 16), __uint_as_float(rg[i].y & 0xffff0000u)};
                  *(LAS f32x4*)(tile + rr * 256 + ch) = (f32x4){a.x * sigmoid_fast(gt.x), a.y * sigmoid_fast(gt.y), a.z * sigmoid_fast(gt.z), a.w * sigmoid_fast(gt.w)}; } } }
        __syncthreads();
        f32x4 acc[8];
#pragma unroll
        for (int o = 0; o < 8; ++o) acc[o] = bias;
#pragma unroll
        for (int rr = 0; rr < 38; ++rr) { const f32x4 v = *(const LAS f32x4*)(tile + (wave * 8 + rr) * 256 + ch);
#pragma unroll
            for (int o = 0; o < 8; ++o) { const int j = rr - o; if (j >= 0 && j < 31) acc[o] += w[j] * v; } }
#pragma unroll
        for (int o = 0; o < 8; ++o) { const size_t row = (size_t)(s0 + t0 + wave * 8 + o);
            const float mu = wave_sum_fast(sum4(acc[o])) * (1.f / 256.f); const f32x4 d = acc[o] - mu;
            const float rstd = rsqrtf(wave_sum_fast(sum4(d * d)) * (1.f / 256.f) + EPS);
            const f32x4 z = d * rstd * g1 + b1;
            const f32x4 sw = (f32x4){z.x * sigmoid_fast(z.x), z.y * sigmoid_fast(z.y), z.z * sigmoid_fast(z.z), z.w * sigmoid_fast(z.w)};
            const float r2 = rsqrtf(wave_sum_fast(sum4(sw * sw)) * (1.f / 256.f) + EPS);
            st_bf4(YMIX + row * D + 256 + ch, sw * r2 * g2); }
        __syncthreads();
    }
}

constexpr int VT_STRIDE = 272;
__device__ __forceinline__ void item_C(const bf16_t* __restrict__ P, const float* __restrict__ lg, const float* __restrict__ lb, const bf16_t* __restrict__ Wb  ,
                                       const float* __restrict__ bs  , const float* __restrict__ gg  , bf16_t* __restrict__ YMIX, LAS unsigned char* lds, int r0, int wave, int lane) {
    LAS unsigned char* VT = lds;
    LAS float* hs = (LAS float*)(lds + 256 * VT_STRIDE);
    { const int ch = lane * 4; const f32x4 g1 = *(const f32x4*)(lg + ch), b1 = *(const f32x4*)(lb + ch);
      uint2 raw[16];
#pragma unroll
      for (int i = 0; i < 16; ++i) raw[i] = *(const uint2*)(P + (size_t)(r0 + wave * 16 + i) * INC + OFF_C + 256 + ch);
#pragma unroll
      for (int i = 0; i < 16; ++i) { const int q = wave * 16 + i;
          const f32x4 pv = (f32x4){__uint_as_float(raw[i].x << 16), __uint_as_float(raw[i].x & 0xffff0000u), __uint_as_float(raw[i].y << 16), __uint_as_float(raw[i].y & 0xffff0000u)};
          const f32x4 v = (f32x4){gelu_fast(pv.x), gelu_fast(pv.y), gelu_fast(pv.z), gelu_fast(pv.w)};
          const float mu = wave_sum_fast(sum4(v)) * (1.f / 256.f); const f32x4 d = v - mu;
          const float rstd = rsqrtf(wave_sum_fast(sum4(d * d)) * (1.f / 256.f) + EPS);
          const f32x4 vn = d * rstd * g1 + b1;
          LAS bf16_t* dst = (LAS bf16_t*)(VT + (size_t)ch * VT_STRIDE + q * 2);
          dst[0] = f2bf(vn.x); dst[VT_STRIDE / 2] = f2bf(vn.y); dst[2 * (VT_STRIDE / 2)] = f2bf(vn.z); dst[3 * (VT_STRIDE / 2)] = f2bf(vn.w); } }
    __syncthreads();
    const int h = wave >> 1, ph = wave & 1, l15 = lane & 15, kq = lane >> 4;
    f32x4 acc[4][4];
#pragma unroll
    for (int mi = 0; mi < 4; ++mi)
#pragma unroll
        for (int ni = 0; ni < 4; ++ni) acc[mi][ni] = (f32x4){0.f, 0.f, 0.f, 0.f};
#pragma unroll
    for (int ks = 0; ks < 4; ++ks) {
        bf16x8 af[4], bf[4];
#pragma unroll
        for (int mi = 0; mi < 4; ++mi) af[mi] = *(const LAS bf16x8*)(VT + (size_t)(64 * h + 16 * mi + l15) * VT_STRIDE + (32 * ks + 8 * kq) * 2);
#pragma unroll
        for (int ni = 0; ni < 4; ++ni) bf[ni] = *(const bf16x8*)(Wb + ((size_t)h * 128 + 64 * ph + 16 * ni + l15) * 128 + 32 * ks + 8 * kq);
#pragma unroll
        for (int mi = 0; mi < 4; ++mi)
#pragma unroll
            for (int ni = 0; ni < 4; ++ni) acc[mi][ni] = __builtin_amdgcn_mfma_f32_16x16x32_bf16(af[mi], bf[ni], acc[mi][ni], 0, 0, 0);
    }
    float ssq[4];
#pragma unroll
    for (int ni = 0; ni < 4; ++ni) { const int p = 64 * ph + 16 * ni + l15; const float bsp = bs[h * 128 + p]; float s = 0.f;
#pragma unroll
        for (int mi = 0; mi < 4; ++mi) { const int ch = 64 * h + 16 * mi + 4 * kq; const f32x4 pu = ld_bf4(P + (size_t)(r0 + p) * INC + OFF_C + ch);
            const f32x4 u = (f32x4){gelu_fast(pu.x), gelu_fast(pu.y), gelu_fast(pu.z), gelu_fast(pu.w)};
            acc[mi][ni] = (acc[mi][ni] + bsp) * u; s += sum4(acc[mi][ni] * acc[mi][ni]); }
        s += __shfl_xor(s, 16); s += __shfl_xor(s, 32); ssq[ni] = s;
        if (kq == 0) hs[p * 4 + h] = s; }
    __syncthreads();
#pragma unroll
    for (int ni = 0; ni < 4; ++ni) { const int p = 64 * ph + 16 * ni + l15; const f32x4 t = *(const LAS f32x4*)(hs + p * 4);
        const float rstd = rsqrtf(sum4(t) * (1.f / 256.f) + EPS);
#pragma unroll
        for (int mi = 0; mi < 4; ++mi) { const int ch = 64 * h + 16 * mi + 4 * kq; const f32x4 g2 = *(const f32x4*)(gg + ch);
            st_bf4(YMIX + (size_t)(r0 + p) * D + 512 + ch, acc[mi][ni] * rstd * g2); } }
    __syncthreads();
}

constexpr int KS = 528, VS = 576, KVBUF = 64 * KS + 64 * VS;
constexpr int HS_OFF = 2 * KVBUF;
__device__ __forceinline__ s16x4 trd(const LAS unsigned char* p) { typedef short v4i16_t __attribute__((ext_vector_type(4))); return __builtin_bit_cast(s16x4, __builtin_amdgcn_ds_read_tr16_b64_v4i16((LAS v4i16_t*)p)); }
__device__ __forceinline__ void item_D(const bf16_t* __restrict__ P, const bf16_t* __restrict__ biasT  , const float* __restrict__ gg  ,
                                       bf16_t* __restrict__ YMIX, LAS unsigned char* lds, int qrow0, int b, int gr, int tid, int wave, int lane, int xf) {
    (void)xf;
    const int h = wave >> 1, qh = wave & 1, l31 = lane & 31, hg = lane >> 5;
    const int nloc = gr >= 0 ? 8 : 0, ntile = nloc + 4, kr0 = gr >= 0 ? min(max(gr - 4, 0), GROWS - 8) : 0;
    bf16x8 qf[4];
    { const bf16_t* qp = P + (size_t)(qrow0 + 32 * qh + l31) * INC + OFF_D + 64 * h + 8 * hg;
#pragma unroll
      for (int s = 0; s < 4; ++s) { const u32x4 raw = *(const u32x4*)(qp + 16 * s); u32x4 o;
#pragma unroll
          for (int i = 0; i < 4; ++i) { const float lo = __uint_as_float(raw[i] << 16) * (0.125f * LOG2E), hi = __uint_as_float(raw[i] & 0xffff0000u) * (0.125f * LOG2E); o[i] = cvtpk(lo, hi); }
          qf[s] = __builtin_bit_cast(bf16x8, o); } }
    bf16x8 oh[2];
#pragma unroll
    for (int s = 0; s < 2; ++s)
#pragma unroll
        for (int j = 0; j < 8; ++j) oh[s][j] = (16 * s + 8 * hg + j == l31) ? (short)0x3F80 : (short)0;
    u32x4 kA[4], vA[4];
#define MXD_SRC(j) ((j) < nloc ? (size_t)b * SEQ + (size_t)(kr0 + (j)) * GRID_W : (size_t)MLAT + (size_t)b * NCTX + (size_t)((j) - nloc) * 64)
#define MXD_LOAD(kr_, vr_, j) do { const size_t rb_ = MXD_SRC(j); _Pragma("unroll") for (int i_ = 0; i_ < 4; ++i_) { const int id_ = tid + NTHR * i_, row_ = id_ >> 5, c_ = id_ & 31; \
        const bf16_t* src_ = P + (rb_ + row_) * INC + OFF_KV + 8 * c_; kr_[i_] = *(const u32x4*)src_; vr_[i_] = *(const u32x4*)(src_ + 256); } } while (0)
#define MXD_STORE(kr_, vr_, buf) do { _Pragma("unroll") for (int i_ = 0; i_ < 4; ++i_) { const int id_ = tid + NTHR * i_, row_ = id_ >> 5, c_ = id_ & 31; \
        *(LAS u32x4*)(lds + (buf) * KVBUF + row_ * KS + c_ * 16) = kr_[i_]; *(LAS u32x4*)(lds + (buf) * KVBUF + 64 * KS + row_ * VS + c_ * 16) = vr_[i_]; } } while (0)
    f32x16 o0 = {}, o1 = {}, negm = {};
    float mref = 0.f, lsum = 0.f;
    const int trq = (lane & 15) >> 2, trp = lane & 3, trb = (lane >> 4) & 1;
    bf16x8 bfr[4];
    const bf16_t* btb = biasT + ((((size_t)(h * 15) * 2 + qh) * 4) * 64 + lane) * 8;
#define MXD_BIAS(j) do { const int dr_ = kr0 + (j) - gr + 7; _Pragma("unroll") for (int f_ = 0; f_ < 4; ++f_) bfr[f_] = *(const bf16x8*)(btb + (size_t)dr_ * 4096 + f_ * 512); } while (0)
#define MXD_COMPUTE(j, buf) do { \
        const LAS unsigned char* Kb = lds + (buf) * KVBUF; const LAS unsigned char* Vb = Kb + 64 * KS; \
        bf16x8 ka0[4], ka1[4]; \
        _Pragma("unroll") for (int s = 0; s < 4; ++s) { ka0[s] = *(const LAS bf16x8*)(Kb + l31 * KS + (64 * h + 16 * s + 8 * hg) * 2); ka1[s] = *(const LAS bf16x8*)(Kb + (32 + l31) * KS + (64 * h + 16 * s + 8 * hg) * 2); } \
        f32x16 p0, p1; \
        if ((j) < nloc) { \
            p0 = __builtin_amdgcn_mfma_f32_32x32x16_bf16(bfr[0], oh[0], negm, 0, 0, 0); p1 = __builtin_amdgcn_mfma_f32_32x32x16_bf16(bfr[2], oh[0], negm, 0, 0, 0); \
            p0 = __builtin_amdgcn_mfma_f32_32x32x16_bf16(bfr[1], oh[1], p0, 0, 0, 0); p1 = __builtin_amdgcn_mfma_f32_32x32x16_bf16(bfr[3], oh[1], p1, 0, 0, 0); \
            if ((j) + 1 < nloc) MXD_BIAS((j) + 1); \
        } else { p0 = negm; p1 = negm; } \
        _Pragma("unroll") for (int s = 0; s < 4; ++s) { p0 = __builtin_amdgcn_mfma_f32_32x32x16_bf16(ka0[s], qf[s], p0, 0, 0, 0); p1 = __builtin_amdgcn_mfma_f32_32x32x16_bf16(ka1[s], qf[s], p1, 0, 0, 0); } \
          \
        s16x4 vf[16]; \
        _Pragma("unroll") for (int kb = 0; kb < 2; ++kb) _Pragma("unroll") for (int s = 0; s < 2; ++s) { \
            const LAS unsigned char* vp = Vb + (32 * kb + 16 * s + 4 * hg + trq) * VS + (64 * h + 16 * trb + 4 * trp) * 2; \
            vf[(kb * 2 + s) * 4 + 0] = trd(vp); vf[(kb * 2 + s) * 4 + 1] = trd(vp + 8 * VS); vf[(kb * 2 + s) * 4 + 2] = trd(vp + 64); vf[(kb * 2 + s) * 4 + 3] = trd(vp + 8 * VS + 64); } \
          \
        float mt = fmaxf(p0[0], p1[0]); \
        _Pragma("unroll") for (int r = 1; r < 16; ++r) mt = fmaxf(mt, fmaxf(p0[r], p1[r])); \
        { const auto rr_ = __builtin_amdgcn_permlane32_swap(__float_as_uint(mt), __float_as_uint(mt), false, false); mt = fmaxf(__uint_as_float(rr_[0]), __uint_as_float(rr_[1])); } \
        if ((j) == 0 || __any(mt > 8.f)) { \
            const float d_ = (j) == 0 ? mt : fmaxf(mt, 0.f); mref += d_; \
            _Pragma("unroll") for (int r = 0; r < 16; ++r) { p0[r] -= d_; p1[r] -= d_; } \
            const float al_ = __builtin_amdgcn_exp2f(-d_); lsum *= al_; \
            _Pragma("unroll") for (int r = 0; r < 16; ++r) { o0[r] *= al_; o1[r] *= al_; negm[r] = -mref; } \
        } \
        float ps = 0.f; \
        _Pragma("unroll") for (int r = 0; r < 16; ++r) { p0[r] = __builtin_amdgcn_exp2f(p0[r]); p1[r] = __builtin_amdgcn_exp2f(p1[r]); ps += p0[r] + p1[r]; } \
        lsum += ps; \
        _Pragma("unroll") for (int kb = 0; kb < 2; ++kb) _Pragma("unroll") for (int s = 0; s < 2; ++s) { \
                u32x4 pw; \
                _Pragma("unroll") for (int i = 0; i < 4; ++i) pw[i] = kb == 0 ? cvtpk(p0[8 * s + 2 * i], p0[8 * s + 2 * i + 1]) : cvtpk(p1[8 * s + 2 * i], p1[8 * s + 2 * i + 1]); \
                const bf16x8 pf = __builtin_bit_cast(bf16x8, pw); \
                const s16x4 a00 = vf[(kb * 2 + s) * 4 + 0], a01 = vf[(kb * 2 + s) * 4 + 1], a10 = vf[(kb * 2 + s) * 4 + 2], a11 = vf[(kb * 2 + s) * 4 + 3]; \
                const bf16x8 v0 = (bf16x8){a00[0], a00[1], a00[2], a00[3], a01[0], a01[1], a01[2], a01[3]}; \
                const bf16x8 v1 = (bf16x8){a10[0], a10[1], a10[2], a10[3], a11[0], a11[1], a11[2], a11[3]}; \
                o0 = __builtin_amdgcn_mfma_f32_32x32x16_bf16(v0, pf, o0, 0, 0, 0); o1 = __builtin_amdgcn_mfma_f32_32x32x16_bf16(v1, pf, o1, 0, 0, 0); } \
    } while (0)
    MXD_LOAD(kA, vA, 0);
    if (nloc) MXD_BIAS(0);
    MXD_STORE(kA, vA, 0);
    __syncthreads();
    for (int j = 0; j < ntile; ++j) {
        const int buf = j & 1;
        if (j + 1 < ntile) MXD_LOAD(kA, vA, j + 1);
        MXD_COMPUTE(j, buf);
        if (j + 1 < ntile) MXD_STORE(kA, vA, buf ^ 1);
        __syncthreads();
    }
#undef MXD_SRC
#undef MXD_LOAD
#undef MXD_STORE
#undef MXD_BIAS
#undef MXD_COMPUTE
    { const auto rr_ = __builtin_amdgcn_permlane32_swap(__float_as_uint(lsum), __float_as_uint(lsum), false, false); lsum = __uint_as_float(rr_[0]) + __uint_as_float(rr_[1]); }
    const float inv = __builtin_amdgcn_rcpf(lsum);
    float ssq = 0.f;
#pragma unroll
    for (int r = 0; r < 16; ++r) { o0[r] *= inv; o1[r] *= inv; ssq += o0[r] * o0[r] + o1[r] * o1[r]; }
    { const auto rr_ = __builtin_amdgcn_permlane32_swap(__float_as_uint(ssq), __float_as_uint(ssq), false, false); ssq = __uint_as_float(rr_[0]) + __uint_as_float(rr_[1]); }
    LAS float* hs = (LAS float*)(lds + HS_OFF);
    const int q = 32 * qh + l31;
    if (hg == 0) hs[q * 4 + h] = ssq;
    __syncthreads();
    const f32x4 t4 = *(const LAS f32x4*)(hs + q * 4);
    const float rstd = rsqrtf(sum4(t4) * (1.f / 256.f) + EPS);
    bf16_t* orow = YMIX + (size_t)(qrow0 + q) * D + 768 + 64 * h;
#pragma unroll
    for (int c = 0; c < 2; ++c)
#pragma unroll
        for (int r4 = 0; r4 < 4; ++r4) { const int d = 32 * c + 8 * r4 + 4 * hg; const f32x4 g2 = *(const f32x4*)(gg + 64 * h + d);
            const f32x4 v = c == 0 ? (f32x4){o0[4 * r4], o0[4 * r4 + 1], o0[4 * r4 + 2], o0[4 * r4 + 3]} : (f32x4){o1[4 * r4], o1[4 * r4 + 1], o1[4 * r4 + 2], o1[4 * r4 + 3]};
            st_bf4(orow + d, v * rstd * g2); }
    __syncthreads();
}

__device__ __forceinline__ void build_tables(const float* __restrict__ sgu_w, const float* __restrict__ rpb, bf16_t* __restrict__ Wb, bf16_t* __restrict__ biasT, int gtid, int ngt) {
    for (int i = gtid; i < 2 * 4 * 128 * 128; i += ngt) Wb[i] = f2bf(sgu_w[i]);
    for (int i = gtid; i < 2 * 4 * 15 * 2 * 2 * 2 * 64 * 8; i += ngt) {
        const int j = i & 7, lane = (i >> 3) & 63, s = (i >> 9) & 1, kb = (i >> 10) & 1, qh = (i >> 11) & 1; int r = i >> 12; const int dr = r % 15; r /= 15; const int h = r & 3, l = r >> 2;
        const int kc = 32 * kb + (lane & 31), qc = 32 * qh + 16 * s + 8 * (lane >> 5) + j, c0 = min(max(qc - 8, 0), GRID_W - 16);
        const bool ok = kc >= c0 && kc < c0 + 16;
        biasT[i] = f2bf(ok ? rpb[((l * 4 + h) * 15 + dr) * 31 + (kc - qc + 15)] * LOG2E : -1e30f);
    }
}
__device__ __forceinline__ void phase(const bf16_t* __restrict__ P, bf16_t* __restrict__ YMIX, const KArgs& a, unsigned char* ws, LAS unsigned char* lds, int l, int vcu, int G, int tid, int wave, int lane0) {
    (void)lane0;
    const int nt128 = (l == 0 ? MT : MLAT) / 128;
    const int nD = 2 * GROWS, nDc = l == 0 ? MCTX / 64 : 0;
    const int total = nD + nDc + 3 * nt128;
    const float* gg = a.in[IN_GG] + l * D;
    const bf16_t* biasT = (const bf16_t*)(ws + WS_BIAS) + (size_t)l * (4 * 15 * 2 * 2 * 2 * 64 * 8);
    const bf16_t* Wb = (const bf16_t*)(ws + WS_SGUW) + (size_t)l * 4 * 128 * 128;
    const int nit = vcu < total ? (total - vcu + G - 1) / G : 0, rsh = (a.flags >> 5) & 7, rot = (a.flags & 4) ? 0 : (vcu >> (rsh ? rsh - 1 : 5)) % (nit > 0 ? nit : 1);
    for (int kk = 0; kk < nit; ++kk) {
        const int it = vcu + ((kk + rot) % nit) * G;
        int r = it;
        asm volatile("" : "+v"(tid));
        const int lane = tid & 63;
        if (r < nD) { const int b = r / GROWS, gr = r % GROWS; if (MX_D && !(a.flags & 128)) item_D(P, biasT, gg + 768, YMIX, lds, b * SEQ + gr * GRID_W, b, gr, tid, wave, lane, a.flags >> 8); continue; }
        r -= nD;
        if (r < nDc) { const int b = r / (NCTX / 64), i = r % (NCTX / 64); if (MX_D && !(a.flags & 128)) item_D(P, biasT, gg + 768, YMIX, lds, MLAT + b * NCTX + i * 64, b, -1, tid, wave, lane, a.flags >> 8); continue; }
        r -= nDc;
        if (r < nt128) { if (MX_C && !(a.flags & 64)) item_C(P, a.in[IN_SLG] + l * 256, a.in[IN_SLB] + l * 256, Wb, a.in[IN_SGB] + l * 4 * 128, gg + 512, YMIX, lds, r * 128, wave, lane); continue; }
        r -= nt128;
        if (r < nt128) { if (MX_B && !(a.flags & 32)) item_B(P, a.in[IN_CBW] + l * 31 * 256, a.in[IN_CBB] + l * 256, a.in[IN_CLG] + l * 256, a.in[IN_CLB] + l * 256, gg + 256, YMIX, lds, r * 128, wave, lane); continue; }
        r -= nt128;
        if (MX_A && !(a.flags & 16)) item_A(P, a.in[IN_CAW] + l * 3 * 256, gg, YMIX, r * 128, wave, lane);
    }
}
}

#ifndef CQ_G10
#define CQ_G10 11500
#define CQ_G20 12000
#define CQ_F10 10500
#define CQ_F20 9008
#endif
#ifndef GEMM_ALIGN
#define GEMM_ALIGN true
#endif
__global__ void __launch_bounds__(NTHR, 2) mk_fwd(KArgs a) {
    extern __shared__ __attribute__((aligned(16))) unsigned char lds_raw[];
    LAS unsigned char* lds = (LAS unsigned char*)lds_raw;
    volatile LAS unsigned* MISC = (volatile LAS unsigned*)(lds + MISC_OFF);
    const LAS unsigned* gtab = (const LAS unsigned*)(lds + GTAB_OFF);
    const int tid0 = threadIdx.x;
    const int wave0 = __builtin_amdgcn_readfirstlane(tid0 >> 6);
    const int G = gridDim.x, blk = blockIdx.x;
    const int vcu = (G % 8 == 0) ? (blk % 8) * (G / 8) + blk / 8 : blk;
    const int ngw = G * NWAVES;
    for (int u = tid0; u < 128; u += NTHR) MISC[u] = 0u;
    __syncthreads();
    unsigned char* ws0 = a.ws;
#define PH_ENTER() int wv_ = wave0; size_t wso_ = 0; asm volatile("" : "+s"(wv_), "+s"(wso_)); int tid = wv_ * 64 + (int)__builtin_amdgcn_mbcnt_hi(~0u, __builtin_amdgcn_mbcnt_lo(~0u, 0u)); asm volatile("" : "+v"(tid)); unsigned char* ws = ws0 + wso_;     const int lane = tid & 63, wave = __builtin_amdgcn_readfirstlane(tid >> 6), gw = vcu * NWAVES + wave; \
    float* mod = (float*)(ws + WS_MOD); float* xc = (float*)(ws + WS_XC); float* xl = a.out; bf16_t* H = (bf16_t*)(ws + WS_H); bf16_t* P = (bf16_t*)(ws + WS_P); bf16_t* Gb = (bf16_t*)(ws + WS_G); bf16_t* YMIX = (bf16_t*)(ws + WS_YMIX); \
    const float* modl = mod + l * 3 * MODW; const float* xl_in = l == 0 ? a.in[IN_X] : xl; const float* xc_in = l == 0 ? a.in[IN_CTX] : xc; \
    (void)lane; (void)wave; (void)gw; (void)mod; (void)xc; (void)xl; (void)H; (void)P; (void)Gb; (void)YMIX; (void)modl; (void)xl_in; (void)xc_in
    XcdBarrier bar = xcd_barrier_post((unsigned*)(ws0 + WS_CTL) + CW_BAR + a.li * XCD_BAR_WORDS, MISC + 8);
    const int lo = a.ph_lo, hi = a.ph_hi;
#define IN(k) (lo <= (k) && (k) < hi)
#define SPARE(nwg_) ((nwg_) % G != 0 && blk >= (nwg_) % G)
#define CONVERT_SHARE(nwg_, i0_, i1_, per_level_, POST_) do { if (SPARE(nwg_) && !(a.flags & 1)) { const int r_ = (nwg_) % G, nidle_ = G - r_, k_ = blk - r_; \
        LAS float* scr_ = (LAS float*)(lds + wave * 16384); for (int it_ = IT_DENSE + (i0_) + k_ * NWAVES + wave; it_ < IT_DENSE + (i1_); it_ += nidle_ * NWAVES) conv_item(a, ws, it_, scr_, lane); } } while (0)
    constexpr int TC1 = CQ_G10, TC2 = TC1 + CQ_G20, TC3 = TC2 + CQ_F10, TC4 = TC3 + CQ_F20;
    static_assert(TC4 <= IT_MOE, "conversion quotas");
#define SEAM(k) do { if (IN(k) && IN((k) + 1)) xcd_barrier(bar); } while (0)

    if (IN(PH_PRO)) { const int l = 0; PH_ENTER();
        ph_convert(a, ws, lds, 0, IT_DENSE, gw, ngw, wave, lane);
        ph_mod(a, ws, lds, blk, G, tid, wave, lane);
#if MIXER_FAST
        mx::build_tables(a.in[IN_SGW], a.in[IN_RPB], (bf16_t*)(ws + WS_SGUW), (bf16_t*)(ws + WS_BIAS), gw * 64 + lane, ngw * 64);
#endif
    }
    SEAM(PH_PRO);

    for (int l = 0; l < 2; ++l) {
        const int pb = l == 0 ? PH_N1_0 : PH_N1_1;
        const int ph_g2 = l == 0 ? PH_G2_0 : PH_G2_1;
        if (IN(pb)) { PH_ENTER(); ph_norm(xl_in, xc_in, a.in[IN_N1G] + l * D, modl, 0, 1, H, MT, gw, ngw, lane, l == 1 ? (const float*)(ws + WS_SLAB0) : nullptr, mod + 2 * MODW + 5 * D); }
        SEAM(pb);
        if (IN(pb + 1)) { PH_ENTER();
            pg8::Gemm g{H, (const bf16_t*)(ws + WS_WIN) + (size_t)l * INC * D, 0, MT, INC, D}; pg8::StaticOrder S; S.init(MT, INC, G, blk);
            pg8::EpiStoreBf16 E{P, INC};
            constexpr int NWG1 = (MT / 256) * (INC / 256);
            pg8::gemm_phase<pg8::EpiStoreBf16, pg8::StaticOrder, false, GEMM_ALIGN>(lds, gtab, g, S, E, tid);
            if (l == 0) CONVERT_SHARE(NWG1, 0, TC1, 1, true); else CONVERT_SHARE(NWG1, TC4, IT_MOE, 1, true);
        }
        SEAM(pb + 1);
        if (IN(pb + 2)) {
#if MIXER_NAIVE_INKERNEL
            const int r1 = l == 1 ? MLAT : MT;
            { PH_ENTER(); float* YRAW = (float*)(ws + WS_YRAW); float* TMPB = (float*)(ws + WS_TMP); float* TMPC = (float*)(ws + WS_TMP2);
              const int vb0 = 2 * blk + (tid >> 8), nvb = 2 * G, ch = tid & 255;
              nv_mixA(P, a.in[IN_CAW] + l * 3 * 256, YRAW, r1, vb0, nvb, ch);
              nv_mixB1(P, a.in[IN_CBW] + l * 31 * 256, a.in[IN_CBB] + l * 256, TMPB, r1, vb0, nvb, ch);
              nv_ln256<1>(nullptr, P, a.in[IN_SLG] + l * 256, a.in[IN_SLB] + l * 256, TMPC, r1, gw, ngw, lane);
              nv_attn(P, a.in[IN_RPB] + l * 4 * 15 * 31, YRAW, r1, gw, ngw, lane, (LAS float*)(lds + wave * 2048)); }
            xcd_barrier(bar);
            { PH_ENTER(); float* YRAW = (float*)(ws + WS_YRAW); float* TMPB = (float*)(ws + WS_TMP); float* TMPC = (float*)(ws + WS_TMP2);
              const int vb0 = 2 * blk + (tid >> 8), nvb = 2 * G, ch = tid & 255;
              nv_ln256<0>(TMPB, P, a.in[IN_CLG] + l * 256, a.in[IN_CLB] + l * 256, YRAW, r1, gw, ngw, lane);
              nv_mixC2(P, TMPC, a.in[IN_SGW] + (size_t)l * 4 * 128 * 128, a.in[IN_SGB] + l * 4 * 128, YRAW, r1, vb0, nvb, ch); }
            xcd_barrier(bar);
            { PH_ENTER(); float* YRAW = (float*)(ws + WS_YRAW);
              nv_groupnorm(YRAW, a.in[IN_GG] + l * D, YMIX, r1, gw, ngw, lane); }
#if MIXER_FAST
            xcd_barrier(bar);
#endif
#endif
#if MIXER_FAST
            { PH_ENTER(); mx::phase(P, YMIX, a, ws, lds, l, vcu, G, tid, wave, lane); }
#endif
        }
        SEAM(pb + 2);
        if (l == 1) {
            if (IN(PH_MOECONV) && (a.flags & 1)) { PH_ENTER(); ph_convert(a, ws, lds, IT_DENSE, IT_DENSE + IT_MOE, gw, ngw, wave, lane); }
            SEAM(PH_MOECONV);
        }
        if (IN(ph_g2)) { PH_ENTER();
            const int rows = l == 0 ? MT : MLAT;
            pg8::Gemm g{YMIX, (const bf16_t*)(ws + WS_WOUT) + (size_t)l * D * D, 0, rows, D, D}; pg8::StaticOrder S; S.init(rows, D, G, blk);
            pg8::EpiResid E{xl_in, xc_in, xl, xc, modl + 2 * D, nullptr};
            constexpr int NWG2 = (MT / 256) * (D / 256);
            pg8::gemm_phase<pg8::EpiResid, pg8::StaticOrder, false, GEMM_ALIGN>(lds, gtab, g, S, E, tid);
            if (l == 0) CONVERT_SHARE(NWG2, TC1, TC2, 1, true);
        }
        SEAM(ph_g2);
        if (l == 0) {
            if (IN(PH_N2_0)) { PH_ENTER(); ph_norm(xl, xc, a.in[IN_N2G] + l * D, modl, 3, 4, H, MT, gw, ngw, lane); }
            SEAM(PH_N2_0);
            if (IN(PH_F1_0)) { PH_ENTER();
                pg8::Gemm g{H, (const bf16_t*)(ws + WS_W13), 0, MT, 2 * DFF, D}; pg8::StaticOrder S; S.init(MT, 2 * DFF, G, blk);
                pg8::EpiSwiglu E{Gb, DFF};
                constexpr int NWF1 = (MT / 256) * (2 * DFF / 256);
                pg8::gemm_phase<pg8::EpiSwiglu, pg8::StaticOrder, false, GEMM_ALIGN>(lds, gtab, g, S, E, tid);
                CONVERT_SHARE(NWF1, TC2, TC3, 1, true);
            }
            SEAM(PH_F1_0);
            if (IN(PH_F2_0)) { PH_ENTER();
                pg8::Gemm g{Gb, (const bf16_t*)(ws + WS_W2), 0, MT, D, DFF}; pg8::DenseTailOrder S; S.init(MLAT, D, G, blk, MCTX / 256, F2_SPLITK, F2_NKT);
                pg8::EpiResid E{xl, xc, xl, xc, modl + 5 * D, (float*)(ws + WS_SLAB0)};
                pg8::gemm_phase<pg8::EpiResid, pg8::DenseTailOrder, false, GEMM_ALIGN>(lds, gtab, g, S, E, tid);
                constexpr int NWF2 = (MCTX / 256) * (D / 256) * F2_SPLITK;
                CONVERT_SHARE(NWF2, TC3, TC4, 2, true);
            }
            SEAM(PH_F2_0);
        } else {
            if (IN(PH_RT)) { PH_ENTER(); ph_route(a, ws, lds, xl, a.in[IN_N2G] + l * D, modl, blk, tid, wave, lane); }
            SEAM(PH_RT);
            if (IN(PH_PLAN)) { PH_ENTER(); ph_plan(ws, lds, blk, tid); }
            SEAM(PH_PLAN);
            for (int pass = 0; pass < 2; ++pass) {
                const int ph1 = pass == 0 ? PH_M1A : PH_M1B;
                if (IN(ph1)) { PH_ENTER(); const int* ebase = (const int*)(ws + WS_SLOT + SLOT_EBASE); const int* slot_tok = (const int*)(ws + WS_SLOT + SLOT_TOK);
                    pg8::GroupedOrder S; S.init(ebase + pass * 9, 2 * DFE, G, blk);
                    { pg8::Unit u; LAS unsigned* gt = (LAS unsigned*)(lds + GTAB_OFF);
                      for (int i = 0; i < 16 && S.next(i, u); ++i) if (tid < 256) { const int tok = slot_tok[pass * PASS_ROWS + u.pm * 256 + tid]; gt[i * 256 + tid] = (unsigned)(tok < 0 ? 0 : tok) * (unsigned)(D * 2); } }
                    __syncthreads();
                    pg8::Gemm g{H, (const bf16_t*)(ws + WS_MW13), (size_t)2 * DFE * D * 2, 0, 2 * DFE, D};
                    pg8::EpiSwiglu E{Gb, DFE};
                    pg8::gemm_phase<pg8::EpiSwiglu, pg8::GroupedOrder, true, GEMM_ALIGN>(lds, gtab, g, S, E, tid);
                }
                SEAM(ph1);
                if (IN(ph1 + 1)) { PH_ENTER(); const int* ebase = (const int*)(ws + WS_SLOT + SLOT_EBASE); const int* slot_tok = (const int*)(ws + WS_SLOT + SLOT_TOK); const float* slot_gate = (const float*)(ws + WS_SLOT + SLOT_GATE);
                    pg8::GroupedTailOrder S; S.init(ebase + pass * 9, D, G, blk);
                    pg8::Gemm g{Gb, (const bf16_t*)(ws + WS_MW2), (size_t)D * DFE * 2, 0, D, DFE};
                    pg8::EpiMoeDown E{xl, slot_tok + pass * PASS_ROWS, slot_gate + pass * PASS_ROWS, modl + 5 * D, (float*)(ws + (pass == 0 ? WS_SLAB0 : WS_H))};
                    pg8::gemm_phase<pg8::EpiMoeDown, pg8::GroupedTailOrder, false, GEMM_ALIGN>(lds, gtab, g, S, E, tid);
                }
                SEAM(ph1 + 1);
            }
            if (IN(PH_FIN)) { PH_ENTER(); ph_final(xl, a.in[IN_FG], ws, modl + 5 * D, gw, ngw, lane); }
        }
    }
#undef IN
#undef SEAM
}

extern "C" void kernel_launch(void* const* d_in, const int* in_sizes, int n_in, void* d_out, int out_size, void* d_ws, size_t ws_size, hipStream_t stream) {
    static int ready = 0;
    if (ready == 0) {
        ready = -1;
        if (n_in != 30 || out_size != MLAT * D || in_sizes[0] != MLAT * D || ws_size < WS_END) { fprintf(stderr, "kernel_launch: unexpected shapes / workspace (%d inputs, out %d, ws %zu)\n", n_in, out_size, ws_size); return; }
        int dev = 0, cus = 0;
        if (hipGetDevice(&dev) != hipSuccess || hipDeviceGetAttribute(&cus, hipDeviceAttributeMultiprocessorCount, dev) != hipSuccess) return;
        if (cus < NBLK) { fprintf(stderr, "kernel_launch: needs %d CUs, device has %d\n", NBLK, cus); return; }
        if (hipFuncSetAttribute((const void*)mk_fwd, hipFuncAttributeMaxDynamicSharedMemorySize, LDS_BYTES) != hipSuccess) { fprintf(stderr, "kernel_launch: hipFuncSetAttribute failed\n"); return; }
        int per_cu = 0;
        if (hipOccupancyMaxActiveBlocksPerMultiprocessor(&per_cu, (const void*)mk_fwd, NTHR, LDS_BYTES) != hipSuccess || per_cu < 1) { fprintf(stderr, "kernel_launch: occupancy query says %d blocks per CU\n", per_cu); (void)hipGetLastError(); return; }
        ready = 1;
    }
    if (ready < 0) return;
    (void)hipMemsetAsync((char*)d_ws + WS_CTL, 0, CTL_ZERO_BYTES, stream);
    KArgs a{};
    for (int i = 0; i < 30; ++i) a.in[i] = (const float*)d_in[i];
    a.out = (float*)d_out; a.ws = (unsigned char*)d_ws;
#if HYBRID
    unsigned char* ws = (unsigned char*)d_ws;
    bf16_t* P = (bf16_t*)(ws + WS_P); bf16_t* YMIX = (bf16_t*)(ws + WS_YMIX); float* YRAW = (float*)(ws + WS_YRAW); float* TMP = (float*)(ws + WS_TMP);
    a.flags = 1;
    const int cuts[4] = {PH_PRO, PH_MIX_0, PH_MIX_1, PH_COUNT};
    for (int li = 0; li < 3; ++li) {
        a.ph_lo = li == 0 ? cuts[0] : cuts[li] + 1; a.ph_hi = cuts[li + 1]; a.li = li;
        hipLaunchKernelGGL(mk_fwd, dim3(NBLK), dim3(NTHR), LDS_BYTES, stream, a);
        if (li < 2) {
            const int l = li; const int r1 = l == 1 ? MLAT : MT;
            k_mixA<<<r1, 256, 0, stream>>>(P, a.in[IN_CAW] + l * 3 * 256, YRAW, 0, r1);
            k_mixB1<<<r1, 256, 0, stream>>>(P, a.in[IN_CBW] + l * 31 * 256, a.in[IN_CBB] + l * 256, TMP, 0, r1);
            k_ln256<0><<<r1 / 4, 256, 0, stream>>>(TMP, P, a.in[IN_CLG] + l * 256, a.in[IN_CLB] + l * 256, YRAW, 0, r1);
            k_ln256<1><<<r1 / 4, 256, 0, stream>>>(nullptr, P, a.in[IN_SLG] + l * 256, a.in[IN_SLB] + l * 256, TMP, 0, r1);
            k_mixC2<<<r1, 256, 0, stream>>>(P, TMP, a.in[IN_SGW] + (size_t)l * 4 * 128 * 128, a.in[IN_SGB] + l * 4 * 128, YRAW, 0, r1);
            k_attn<<<r1, 256, 0, stream>>>(P, a.in[IN_RPB] + l * 4 * 15 * 31, YRAW, 0, r1);
            k_groupnorm<<<r1, 256, 0, stream>>>(YRAW, a.in[IN_GG] + l * D, YMIX, 0, r1);
        }
    }
#elif defined(PROBE_PHASE)
    a.flags = 0; int li = 0;
    a.ph_lo = 0; a.ph_hi = PROBE_PHASE + 1; a.li = li++; hipLaunchKernelGGL(mk_fwd, dim3(NBLK), dim3(NTHR), LDS_BYTES, stream, a);
    a.flags = PROBE_FLAGS; for (int r = 0; r < PROBE_REPS; ++r) { a.ph_lo = PROBE_PHASE; a.ph_hi = PROBE_PHASE + 1; a.li = li++; hipLaunchKernelGGL(mk_fwd, dim3(NBLK), dim3(NTHR), LDS_BYTES, stream, a); }
    a.flags = 0; a.ph_lo = PROBE_PHASE + 1; a.ph_hi = PH_COUNT; a.li = li++; hipLaunchKernelGGL(mk_fwd, dim3(NBLK), dim3(NTHR), LDS_BYTES, stream, a);
#else
    a.flags = MIXER_NAIVE_INKERNEL ? 1 : 0; a.ph_lo = 0; a.ph_hi = PH_COUNT; a.li = 0;
    hipLaunchKernelGGL(mk_fwd, dim3(NBLK), dim3(NTHR), LDS_BYTES, stream, a);
#endif
}
```
